# Optimizing an MI355X kernel written in HIP

```python
import math
import jax, jax.numpy as jnp
from jax import lax
import numpy as np

D_MODEL = 1024
BATCH = 16
SEQ = 2048
DEPTH = 1

DIFF_HEADS = 4
DIFF_HEAD_DIM = 64
DIFF_QK = DIFF_HEADS * 2 * DIFF_HEAD_DIM
DIFF_V = DIFF_HEADS * 2 * DIFF_HEAD_DIM
RWKV_HEAD_DIM = 64
RWKV_WIDTH = D_MODEL // 2
RWKV_HEADS = RWKV_WIDTH // RWKV_HEAD_DIM
DECAY_RANK = 64
ICLR_RANK = 64
GATE_RANK = 128
FFN_HIDDEN = -(-8 * D_MODEL // (3 * 256)) * 256
NUM_BUCKETS = 32
MAX_DISTANCE = 128
Q_BLOCK = 128
LN_EPS = 1e-5
LNX_EPS = 64e-5
NEG_BIG = -1e30
DEEPNORM_ALPHA = (2.0 * DEPTH) ** 0.25
DEEPNORM_BETA = (8.0 * DEPTH) ** -0.25

RWKV_SHIFT_WIDTH = 3 * RWKV_WIDTH + DECAY_RANK + ICLR_RANK + GATE_RANK
IN_SIZES = (DIFF_QK, DIFF_QK, DIFF_V, RWKV_SHIFT_WIDTH, D_MODEL, D_MODEL)
IN_SPLIT = tuple(int(s) for s in np.cumsum(IN_SIZES)[:-1])
W_IN_COLS = int(sum(IN_SIZES))
RWKV_SIZES = (RWKV_WIDTH, RWKV_WIDTH, RWKV_WIDTH, DECAY_RANK, ICLR_RANK, GATE_RANK)
RWKV_SPLIT = tuple(int(s) for s in np.cumsum(RWKV_SIZES)[:-1])

kernel_name = 'hybrid_diffattn_rwkv7_gated_deepnorm'


def _layer_norm(x, g, b, eps=LN_EPS):
    xf = x.astype(jnp.float32)
    mu = jnp.mean(xf, -1, keepdims=True)
    var = jnp.mean(jnp.square(xf - mu), -1, keepdims=True)
    return ((xf - mu) * lax.rsqrt(var + eps) * g + b).astype(x.dtype)


def _rms_norm(x, g, eps=LN_EPS):
    xf = x.astype(jnp.float32)
    return (xf * lax.rsqrt(jnp.mean(xf * xf, -1, keepdims=True) + eps) * g).astype(x.dtype)


def _t5_bucket(dist):
    max_exact = NUM_BUCKETS // 2
    d = jnp.maximum(dist, 1).astype(jnp.float32)
    large = max_exact + (jnp.log(d / max_exact) / math.log(MAX_DISTANCE / max_exact)
                         * (NUM_BUCKETS - max_exact)).astype(jnp.int32)
    large = jnp.minimum(large, NUM_BUCKETS - 1)
    return jnp.where(dist < max_exact, dist, large)


def _diff_attention(q, k, v, lam, rel_bias):
    B, S = q.shape[0], q.shape[1]
    nblk = S // Q_BLOCK
    scale = DIFF_HEAD_DIM ** -0.5
    qb = q.reshape(B, nblk, Q_BLOCK, DIFF_HEADS, 2, DIFF_HEAD_DIM).transpose(1, 0, 2, 3, 4, 5)
    k_pos = jnp.arange(S, dtype=jnp.int32)

    def block(args):
        i, q_blk = args
        q_pos = i * Q_BLOCK + jnp.arange(Q_BLOCK, dtype=jnp.int32)
        dist = q_pos[:, None] - k_pos[None, :]
        bias = rel_bias[_t5_bucket(jnp.maximum(dist, 0))].astype(jnp.float32)
        logits = jnp.einsum('bqhcd,bkhcd->bhcqk', q_blk, k).astype(jnp.float32) * scale
        logits = logits + bias.transpose(2, 0, 1)[None, :, None]
        logits = jnp.where((dist >= 0)[None, None, None], logits, NEG_BIG)
        p = jax.nn.softmax(logits, axis=-1)
        p = p[:, :, 0] - lam * p[:, :, 1]
        return jnp.einsum('bhqk,bkhe->bqhe', p.astype(v.dtype), v)

    out = lax.map(block, (jnp.arange(nblk, dtype=jnp.int32), qb))
    return out.transpose(1, 0, 2, 3, 4).reshape(B, S, DIFF_HEADS, 2 * DIFF_HEAD_DIM)


def _diff_branch(p_q, p_k, p_v, lq1, lk1, lq2, lk2, subln_g, rel_bias, lambda_init):
    B, S = p_q.shape[0], p_q.shape[1]
    q = p_q.reshape(B, S, DIFF_HEADS, 2, DIFF_HEAD_DIM)
    k = p_k.reshape(B, S, DIFF_HEADS, 2, DIFF_HEAD_DIM)
    v = p_v.reshape(B, S, DIFF_HEADS, 2 * DIFF_HEAD_DIM)
    f32 = jnp.float32
    lam = (jnp.exp(jnp.sum(lq1.astype(f32) * lk1.astype(f32)))
           - jnp.exp(jnp.sum(lq2.astype(f32) * lk2.astype(f32))) + lambda_init)
    o = _diff_attention(q, k, v, lam, rel_bias)
    o = _rms_norm(o, subln_g) * (1.0 - lambda_init)
    return o.reshape(B, S, DIFF_HEADS * 2 * DIFF_HEAD_DIM)


def _rwkv7_scan(r, w, k, v, kk, a):
    B, S, H, N = r.shape

    def step(state, inp):
        r_t, w_t, k_t, v_t, kk_t, a_t = inp
        sa = jnp.einsum('bhij,bhj->bhi', state, -kk_t)
        state = (state * w_t[:, :, None, :]
                 + sa[..., None] * (kk_t * a_t)[:, :, None, :]
                 + v_t[..., None] * k_t[:, :, None, :])
        y = jnp.einsum('bhij,bhj->bhi', state, r_t)
        return state, y

    xs = tuple(t.transpose(1, 0, 2, 3) for t in (r, w, k, v, kk, a))
    state0 = jnp.zeros((B, H, N, N), jnp.float32)
    _, ys = lax.scan(step, state0, xs)
    return ys.transpose(1, 0, 2, 3)


def _rwkv_branch(p, mu, w0, w2, a0, a2, g2, k_k, k_a, r_k, lnx_g, lnx_b):
    B, S = p.shape[0], p.shape[1]
    f32 = jnp.float32
    p_prev = jnp.pad(p[:, :-1], ((0, 0), (1, 0), (0, 0)))
    p = p + (p_prev - p) * mu
    r, k, v, wl, al, gl = jnp.split(p, RWKV_SPLIT, axis=-1)
    w = -jax.nn.softplus(-(w0 + jnp.tanh(wl) @ w2)) - 0.5
    decay = jnp.exp(-jnp.exp(w.astype(f32)))
    a = jax.nn.sigmoid(a0 + al @ a2)
    g = jax.nn.sigmoid(gl) @ g2
    heads = lambda t: t.reshape(B, S, RWKV_HEADS, RWKV_HEAD_DIM)
    kk = heads(k * k_k).astype(f32)
    kk = kk * lax.rsqrt(jnp.maximum(jnp.sum(kk * kk, -1, keepdims=True), 1e-24))
    k = k * (1.0 + (a - 1.0) * k_a)
    r_h, k_h, v_h, a_h = heads(r), heads(k), heads(v), heads(a)
    y = _rwkv7_scan(r_h.astype(f32), heads(decay), k_h.astype(f32), v_h.astype(f32),
                    kk, a_h.astype(f32))
    mean = jnp.mean(y, -1, keepdims=True)
    var = jnp.mean(jnp.square(y - mean), -1, keepdims=True)
    y = ((y - mean) * lax.rsqrt(var + LNX_EPS)).reshape(B, S, RWKV_WIDTH) * lnx_g + lnx_b
    bonus = jnp.sum(r_h.astype(f32) * k_h.astype(f32) * r_k, -1, keepdims=True) * v_h.astype(f32)
    y = y + bonus.reshape(B, S, RWKV_WIDTH)
    return (y * g).astype(p.dtype)


def setup_inputs(seed: int = 0) -> dict:
    key = jax.random.key(seed)
    ks = iter(jax.random.split(key, 48))
    L, D, beta = DEPTH, D_MODEL, DEEPNORM_BETA

    def nrm(shape, scale):
        return scale * jax.random.normal(next(ks), shape, jnp.float32)

    x = nrm((BATCH, SEQ, D), 1.0)
    ln_in_g = 1.0 + nrm((D,), 0.02)
    ln_in_b = nrm((D,), 0.02)
    rel_bias = nrm((NUM_BUCKETS, DIFF_HEADS), 0.3)
    w_in = jnp.concatenate([
        nrm((L, D, DIFF_QK), D ** -0.5),
        nrm((L, D, DIFF_QK), D ** -0.5),
        nrm((L, D, DIFF_V), beta * D ** -0.5),
        nrm((L, D, 2 * RWKV_WIDTH), D ** -0.5),
        nrm((L, D, RWKV_WIDTH), beta * D ** -0.5),
        nrm((L, D, DECAY_RANK + ICLR_RANK + GATE_RANK), D ** -0.5),
        nrm((L, D, 2 * D), D ** -0.5),
    ], axis=-1)
    diff_lam_q1 = nrm((L, DIFF_HEAD_DIM), 0.1)
    diff_lam_k1 = nrm((L, DIFF_HEAD_DIM), 0.1)
    diff_lam_q2 = nrm((L, DIFF_HEAD_DIM), 0.1)
    diff_lam_k2 = nrm((L, DIFF_HEAD_DIM), 0.1)
    diff_subln_g = 1.0 + nrm((L, 2 * DIFF_HEAD_DIM), 0.02)
    rwkv_mu = jax.random.uniform(next(ks), (L, RWKV_SHIFT_WIDTH), jnp.float32)
    rwkv_w0 = jnp.broadcast_to(jnp.linspace(-6.0, -1.0, RWKV_WIDTH, dtype=jnp.float32),
                               (L, RWKV_WIDTH)) + nrm((L, RWKV_WIDTH), 0.1)
    rwkv_w2 = nrm((L, DECAY_RANK, RWKV_WIDTH), 0.5 * DECAY_RANK ** -0.5)
    rwkv_a0 = nrm((L, RWKV_WIDTH), 0.1)
    rwkv_a2 = nrm((L, ICLR_RANK, RWKV_WIDTH), 0.5 * ICLR_RANK ** -0.5)
    rwkv_g2 = nrm((L, GATE_RANK, RWKV_WIDTH), GATE_RANK ** -0.5)
    rwkv_k_k = 0.85 + nrm((L, RWKV_WIDTH), 0.02)
    rwkv_k_a = 1.0 + nrm((L, RWKV_WIDTH), 0.02)
    rwkv_r_k = nrm((L, RWKV_HEADS, RWKV_HEAD_DIM), 0.1)
    rwkv_lnx_g = 1.0 + nrm((L, RWKV_WIDTH), 0.02)
    rwkv_lnx_b = nrm((L, RWKV_WIDTH), 0.02)
    w_up_a = nrm((L, DIFF_V, D), beta * DIFF_V ** -0.5)
    w_up_b = nrm((L, RWKV_WIDTH, D), beta * RWKV_WIDTH ** -0.5)
    w_out = nrm((L, D, D), beta * D ** -0.5)
    ln1_g = 1.0 + nrm((L, D), 0.02)
    ln1_b = nrm((L, D), 0.02)
    ffn_w_gate = nrm((L, D, FFN_HIDDEN), beta * D ** -0.5)
    ffn_w_up = nrm((L, D, FFN_HIDDEN), beta * D ** -0.5)
    ffn_w_down = nrm((L, FFN_HIDDEN, D), beta * FFN_HIDDEN ** -0.5)
    ln2_g = 1.0 + nrm((L, D), 0.02)
    ln2_b = nrm((L, D), 0.02)
    return {'x': x, 'ln_in_g': ln_in_g, 'ln_in_b': ln_in_b, 'rel_bias': rel_bias,
            'w_in': w_in, 'diff_lam_q1': diff_lam_q1, 'diff_lam_k1': diff_lam_k1,
            'diff_lam_q2': diff_lam_q2, 'diff_lam_k2': diff_lam_k2,
            'diff_subln_g': diff_subln_g, 'rwkv_mu': rwkv_mu, 'rwkv_w0': rwkv_w0,
            'rwkv_w2': rwkv_w2, 'rwkv_a0': rwkv_a0, 'rwkv_a2': rwkv_a2, 'rwkv_g2': rwkv_g2,
            'rwkv_k_k': rwkv_k_k, 'rwkv_k_a': rwkv_k_a, 'rwkv_r_k': rwkv_r_k,
            'rwkv_lnx_g': rwkv_lnx_g, 'rwkv_lnx_b': rwkv_lnx_b, 'w_up_a': w_up_a,
            'w_up_b': w_up_b, 'w_out': w_out, 'ln1_g': ln1_g, 'ln1_b': ln1_b,
            'ffn_w_gate': ffn_w_gate, 'ffn_w_up': ffn_w_up, 'ffn_w_down': ffn_w_down,
            'ln2_g': ln2_g, 'ln2_b': ln2_b}


def reference(x, ln_in_g, ln_in_b, rel_bias, w_in, diff_lam_q1, diff_lam_k1, diff_lam_q2,
              diff_lam_k2, diff_subln_g, rwkv_mu, rwkv_w0, rwkv_w2, rwkv_a0, rwkv_a2, rwkv_g2,
              rwkv_k_k, rwkv_k_a, rwkv_r_k, rwkv_lnx_g, rwkv_lnx_b, w_up_a, w_up_b, w_out,
              ln1_g, ln1_b, ffn_w_gate, ffn_w_up, ffn_w_down, ln2_g, ln2_b):
    h = _layer_norm(x, ln_in_g, ln_in_b)
    for l in range(DEPTH):
        lambda_init = 0.8 - 0.6 * math.exp(-0.3 * l)
        proj = h @ w_in[l]
        p_q, p_k, p_v, p_rwkv, p_ga, p_gb = jnp.split(proj, IN_SPLIT, axis=-1)
        y_a = _diff_branch(p_q, p_k, p_v, diff_lam_q1[l], diff_lam_k1[l], diff_lam_q2[l],
                           diff_lam_k2[l], diff_subln_g[l], rel_bias, lambda_init)
        y_b = _rwkv_branch(p_rwkv, rwkv_mu[l], rwkv_w0[l], rwkv_w2[l], rwkv_a0[l],
                           rwkv_a2[l], rwkv_g2[l], rwkv_k_k[l], rwkv_k_a[l], rwkv_r_k[l],
                           rwkv_lnx_g[l], rwkv_lnx_b[l])
        merged = (jax.nn.sigmoid(p_ga) * (y_a @ w_up_a[l])
                  + jax.nn.sigmoid(p_gb) * (y_b @ w_up_b[l]))
        mix = merged @ w_out[l]
        h = _layer_norm(DEEPNORM_ALPHA * h + mix, ln1_g[l], ln1_b[l])
        ffn = (jax.nn.silu(h @ ffn_w_gate[l]) * (h @ ffn_w_up[l])) @ ffn_w_down[l]
        h = _layer_norm(DEEPNORM_ALPHA * h + ffn, ln2_g[l], ln2_b[l])
    return h
```

```cpp
#include <hip/hip_runtime.h>
#include <cstdio>
#include <cstdint>
#include <cmath>

#ifndef MK_ONE_LAUNCH
#define MK_ONE_LAUNCH 0
#endif

constexpr int MTOK = 32768, DM = 1024, SEQ = 2048, NBATCH = 16;
constexpr int NPROJ = 5376, FFH = 2816;
constexpr float C2 = 0.125f * 1.4426950408889634f;
constexpr float LOG2E = 1.4426950408889634f;
constexpr float ALPHA = 1.189207115002721f;
constexpr float LN_EPS = 1e-5f, LNX_EPS = 64e-5f;

namespace pg8 {
#define PG8_LAS __attribute__((address_space(3)))
typedef unsigned short bf16_t;
typedef short bf16x8 __attribute__((ext_vector_type(8)));
typedef float f32x4 __attribute__((ext_vector_type(4)));
typedef unsigned u32x4 __attribute__((ext_vector_type(4)));
constexpr int BM = 256, BK = 64, HALF = 128, HTB = HALF * BK * 2  , STAGE_BYTES = 8 * HTB, NXCD = 8, WGM = 8;

__host__ __device__ __forceinline__ int lds_byte(int r, int c) { const int st = (r >> 4) * 2 + (c >> 5), rr = r & 15, cc = c & 31, ob = rr * 64 + cc * 2; return st * 1024 + (ob ^ (((ob >> 9) & 1) << 5)); }
__host__ __device__ __forceinline__ void stage_rc(int b, int& R, int& C) { const int st = b / 1024, sb = b % 1024, swz = sb ^ (((sb >> 9) & 1) << 5); R = (st >> 1) * 16 + swz / 64; C = (st & 1) * 32 + (swz % 64) / 2; }
__host__ __device__ __forceinline__ int perm32(int rho) { const int n = rho >> 4, i = rho & 15; return 8 * (i >> 2) + 4 * n + (i & 3); }

struct Unit { int pm, pn; };
struct Gemm { const bf16_t* A; const bf16_t* Bt; int M, N, K; };

struct StaticOrder {
    int nM, nN, nwg, G, c;
    __host__ __device__ void init(int M, int N, int G_, int c_) { nM = M / BM; nN = N / BM; nwg = nM * nN; G = G_; c = c_; }
    __host__ __device__ bool next(int i, Unit& u) const {
        const long L = (long)i * G + c; if (L >= nwg) return false;
        int wgid = (int)L; { const int q = nwg / NXCD, r = nwg % NXCD, xcd = wgid % NXCD, off = wgid / NXCD; wgid = (xcd < r ? xcd * (q + 1) : r * (q + 1) + (xcd - r) * q) + off; }
        const int nig = WGM * nN, gid = wgid / nig, fm = gid * WGM, gsz = (nM - fm) < WGM ? (nM - fm) : WGM;
        u.pm = fm + ((wgid % nig) % gsz); u.pn = (wgid % nig) / gsz; return true;
    }
    __device__ __forceinline__ void a_ready(const Unit&) const {}
    __device__ __forceinline__ void done(const Unit&) const {}
};

__device__ __forceinline__ unsigned cvt_pk_bf16(float lo, float hi) { unsigned r; asm volatile("v_cvt_pk_bf16_f32 %0, %1, %2" : "=v"(r) : "v"(lo), "v"(hi)); return r; }
__device__ __forceinline__ float bf_lo(unsigned w) { return __builtin_bit_cast(float, w << 16); }
__device__ __forceinline__ float bf_hi(unsigned w) { return __builtin_bit_cast(float, w & 0xffff0000u); }
__device__ __forceinline__ float sigmoid_f(float x) { return __builtin_amdgcn_rcpf(1.0f + __builtin_amdgcn_exp2f(-x * 1.4426950408889634f)); }
typedef unsigned u32x2 __attribute__((ext_vector_type(2)));
struct EpiProj {
    static constexpr bool PERM = true, AFTER_DRAIN = false;
    bf16_t* Q; bf16_t* RW; bf16_t* GT;
    __device__ __forceinline__ void operator()(const f32x4 (&acc)[2][2][4][2], const Unit& u, int wr, int wc, int fr, int fq) const {
        const int row0 = u.pm * BM + wr * 64 + fr; const int colt = u.pn * BM;
        bf16_t* base; int ldc, c0; float sc = 1.f; bool sig = false;
        if (colt < 1536) { const int t = colt >> 9; base = Q + (size_t)t * ((size_t)MTOK * 512); ldc = 512; c0 = colt & 511; if (t == 0) sc = C2; }
        else if (colt < 3328) { base = RW; ldc = 1792; c0 = colt - 1536; }
        else { base = GT; ldc = 2048; c0 = colt - 3328; sig = true; }
        const int col0 = c0 + wc * 32 + 8 * fq;
#pragma unroll
        for (int ai = 0; ai < 2; ++ai)
#pragma unroll
            for (int m = 0; m < 4; ++m) { bf16_t* rowp = base + (size_t)(row0 + ai * HALF + m * 16) * ldc + col0;
#pragma unroll
                for (int bj = 0; bj < 2; ++bj) { f32x4 v0 = acc[ai][bj][m][0], v1 = acc[ai][bj][m][1];
                    if (sig) {
#pragma unroll
                        for (int e = 0; e < 4; ++e) { v0[e] = sigmoid_f(v0[e]); v1[e] = sigmoid_f(v1[e]); } }
                    else { v0 = v0 * sc; v1 = v1 * sc; }
                    u32x4 w; w.x = cvt_pk_bf16(v0[0], v0[1]); w.y = cvt_pk_bf16(v0[2], v0[3]); w.z = cvt_pk_bf16(v1[0], v1[1]); w.w = cvt_pk_bf16(v1[2], v1[3]);
                    *(u32x4*)(rowp + bj * HALF) = w; } }
    }
};
struct EpiLowrank {
    static constexpr bool PERM = false, AFTER_DRAIN = false;
    float* DEC; bf16_t* AA; size_t GGOFF; const float* w0; const float* a0;
    __device__ __forceinline__ void operator()(const f32x4 (&acc)[2][2][4][2], const Unit& u, int wr, int wc, int fr, int fq) const {
        const int row0 = u.pm * BM + wr * 64 + fr; const int colt = u.pn * BM; const int kind = colt >> 9;
        const int cb = (colt & 511) + wc * 32 + 4 * fq;
        bf16_t* dst16 = AA + (kind == 2 ? GGOFF : (size_t)0);
#pragma unroll
        for (int bj = 0; bj < 2; ++bj)
#pragma unroll
            for (int n = 0; n < 2; ++n) { const int c = cb + bj * HALF + n * 16;
                f32x4 bv = (f32x4){0.f, 0.f, 0.f, 0.f};
                if (kind == 0) bv = *(const f32x4*)(w0 + c); else if (kind == 1) bv = *(const f32x4*)(a0 + c);
#pragma unroll
                for (int ai = 0; ai < 2; ++ai)
#pragma unroll
                    for (int m = 0; m < 4; ++m) { const size_t off = (size_t)(row0 + ai * HALF + m * 16) * 512 + c; f32x4 v = acc[ai][bj][m][n] + bv;
                        if (kind == 0) {
#pragma unroll
                            for (int e = 0; e < 4; ++e) { const float y = -v[e];
                                const float sp = fmaxf(y, 0.f) + 0.6931471805599453f * __builtin_amdgcn_logf(1.0f + __builtin_amdgcn_exp2f(-fabsf(y) * LOG2E));
                                const float lam = __builtin_amdgcn_exp2f((-sp - 0.5f) * LOG2E); v[e] = __builtin_amdgcn_exp2f(-lam * LOG2E); }
                            *(f32x4*)(DEC + off) = v;
                        } else {
                            if (kind == 1) {
#pragma unroll
                                for (int e = 0; e < 4; ++e) v[e] = sigmoid_f(v[e]); }
                            u32x2 w; w.x = cvt_pk_bf16(v[0], v[1]); w.y = cvt_pk_bf16(v[2], v[3]);
                            *(u32x2*)(dst16 + off) = w; } } }
    }
};
template <int WHICH> struct EpiUp {
    static constexpr bool PERM = true, AFTER_DRAIN = false;
    const bf16_t* GT; bf16_t* T;
    __device__ __forceinline__ void operator()(const f32x4 (&acc)[2][2][4][2], const Unit& u, int wr, int wc, int fr, int fq) const {
        const int row0 = u.pm * BM + wr * 64 + fr; const int col0 = u.pn * BM + wc * 32 + 8 * fq;
#pragma unroll
        for (int ai = 0; ai < 2; ++ai)
#pragma unroll
            for (int m = 0; m < 4; ++m) { const size_t row = (size_t)(row0 + ai * HALF + m * 16);
#pragma unroll
                for (int bj = 0; bj < 2; ++bj) { const int c = col0 + bj * HALF;
                    const u32x4 g = *(const u32x4*)(GT + row * 2048 + WHICH * 1024 + c);
                    const f32x4 v0 = acc[ai][bj][m][0], v1 = acc[ai][bj][m][1];
                    float r[8] = { bf_lo(g.x) * v0[0], bf_hi(g.x) * v0[1], bf_lo(g.y) * v0[2], bf_hi(g.y) * v0[3], bf_lo(g.z) * v1[0], bf_hi(g.z) * v1[1], bf_lo(g.w) * v1[2], bf_hi(g.w) * v1[3] };
                    if (WHICH == 1) { const u32x4 t = *(const u32x4*)(T + row * 1024 + c);
                        r[0] += bf_lo(t.x); r[1] += bf_hi(t.x); r[2] += bf_lo(t.y); r[3] += bf_hi(t.y); r[4] += bf_lo(t.z); r[5] += bf_hi(t.z); r[6] += bf_lo(t.w); r[7] += bf_hi(t.w); }
                    u32x4 w; w.x = cvt_pk_bf16(r[0], r[1]); w.y = cvt_pk_bf16(r[2], r[3]); w.z = cvt_pk_bf16(r[4], r[5]); w.w = cvt_pk_bf16(r[6], r[7]);
                    *(u32x4*)(T + row * 1024 + c) = w; } }
    }
};
struct EpiOutZ {
    static constexpr bool PERM = false, AFTER_DRAIN = false;
    const float* x; const float* stats; const float* g_in; const float* b_in; float* Z;
    __device__ __forceinline__ void operator()(const f32x4 (&acc)[2][2][4][2], const Unit& u, int wr, int wc, int fr, int fq) const {
        const int row0 = u.pm * BM + wr * 64 + fr; const int cb = u.pn * BM + wc * 32 + 4 * fq;
#pragma unroll
        for (int bj = 0; bj < 2; ++bj)
#pragma unroll
            for (int n = 0; n < 2; ++n) { const int c = cb + bj * HALF + n * 16; const f32x4 gi = *(const f32x4*)(g_in + c), bi = *(const f32x4*)(b_in + c);
#pragma unroll
                for (int ai = 0; ai < 2; ++ai)
#pragma unroll
                    for (int m = 0; m < 4; ++m) { const size_t row = (size_t)(row0 + ai * HALF + m * 16); const float mean = stats[row * 2], rstd = stats[row * 2 + 1];
                        const f32x4 xv = *(const f32x4*)(x + row * 1024 + c); const f32x4 h = (xv - mean) * rstd * gi + bi;
                        *(f32x4*)(Z + row * 1024 + c) = h * ALPHA + acc[ai][bj][m][n]; } }
    }
};
struct EpiSwiglu {
    static constexpr bool PERM = true, AFTER_DRAIN = false;
    bf16_t* ACT;
    __device__ __forceinline__ void operator()(const f32x4 (&acc)[2][2][4][2], const Unit& u, int wr, int wc, int fr, int fq) const {
        const int row0 = u.pm * BM + wr * 64 + fr; const int col0 = u.pn * HALF + wc * 32 + 8 * fq;
#pragma unroll
        for (int ai = 0; ai < 2; ++ai)
#pragma unroll
            for (int m = 0; m < 4; ++m) { const size_t row = (size_t)(row0 + ai * HALF + m * 16);
                float r[8];
#pragma unroll
                for (int n = 0; n < 2; ++n)
#pragma unroll
                    for (int e = 0; e < 4; ++e) { const float g = acc[ai][0][m][n][e], up = acc[ai][1][m][n][e]; r[4 * n + e] = g * sigmoid_f(g) * up; }
                u32x4 w; w.x = cvt_pk_bf16(r[0], r[1]); w.y = cvt_pk_bf16(r[2], r[3]); w.z = cvt_pk_bf16(r[4], r[5]); w.w = cvt_pk_bf16(r[6], r[7]);
                *(u32x4*)(ACT + row * FFH + col0) = w; }
    }
};
struct EpiDownZ {
    static constexpr bool PERM = false, AFTER_DRAIN = false;
    float* Z;
    __device__ __forceinline__ void operator()(const f32x4 (&acc)[2][2][4][2], const Unit& u, int wr, int wc, int fr, int fq) const {
        const int row0 = u.pm * BM + wr * 64 + fr; const int cb = u.pn * BM + wc * 32 + 4 * fq;
#pragma unroll
        for (int ai = 0; ai < 2; ++ai)
#pragma unroll
            for (int m = 0; m < 4; ++m) { const size_t row = (size_t)(row0 + ai * HALF + m * 16);
#pragma unroll
                for (int bj = 0; bj < 2; ++bj)
#pragma unroll
                    for (int n = 0; n < 2; ++n) { float* p = Z + row * 1024 + cb + bj * HALF + n * 16; const f32x4 h = *(const f32x4*)p; *(f32x4*)p = h * ALPHA + acc[ai][bj][m][n]; } }
    }
};

template <class Epi, class Sched, bool ALIGN_EPI = false, bool SP2 = false>
__device__ __forceinline__ void gemm_phase(PG8_LAS unsigned char* lds, const Gemm g, const Sched& S, const Epi& E) {
    const int tid = threadIdx.x, wid = __builtin_amdgcn_readfirstlane(tid >> 6), lane = tid & 63, wr = wid >> 2, wc = wid & 3, fr = lane & 15, fq = lane >> 4;
    const int K = g.K, nt = K / BK;
    unsigned voffA[2], voffB[2];
#pragma unroll
    for (int i = 0; i < 2; ++i) { int R, C; stage_rc(tid * 16 + i * 8192, R, C); const int Rb = Epi::PERM ? ((R & ~31) + perm32(R & 31)) : R;
        voffA[i] = (unsigned)(R * K + C) * 2u; voffB[i] = (unsigned)(Rb * K + C) * 2u; }
    const size_t kstep = (size_t)(BK * 2);
    const size_t hstep = (size_t)HALF * K * 2;
    const size_t tstep = 2 * hstep;
    const unsigned ldsw = (unsigned)wid * 1024u;
    const int aoff = lds_byte(wr * 64 + fr, fq * 8), boff = lds_byte(wc * 32 + fr, fq * 8);
#define PG8_SA(b, h) (((b) * 2 + (h)) * HTB)
#define PG8_SB(b, h) ((4 + (b) * 2 + (h)) * HTB)
#define PG8_STAGE(bufoff, gbase, voff) do { _Pragma("unroll") for (int _i = 0; _i < 2; ++_i) \
        __builtin_amdgcn_global_load_lds((const unsigned*)((const char*)(gbase) + (voff)[_i]), (PG8_LAS unsigned*)(lds + (bufoff) + ldsw + _i * 8192), 16, 0, 0); } while (0)
#define PG8_LDA(dst, b, h) do { _Pragma("unroll") for (int m = 0; m < 4; ++m) _Pragma("unroll") for (int k = 0; k < 2; ++k) dst[m][k] = *(const PG8_LAS bf16x8*)(lds + PG8_SA(b, h) + aoff + m * 2048 + k * 1024); } while (0)
#define PG8_LDB(dst, b, h) do { _Pragma("unroll") for (int n = 0; n < 2; ++n) _Pragma("unroll") for (int k = 0; k < 2; ++k) dst[n][k] = *(const PG8_LAS bf16x8*)(lds + PG8_SB(b, h) + boff + n * 2048 + k * 1024); } while (0)
#define PG8_MMA(ai, bj, At, Bt) do { __builtin_amdgcn_s_setprio(1); _Pragma("unroll") for (int m = 0; m < 4; ++m) _Pragma("unroll") for (int n = 0; n < 2; ++n) _Pragma("unroll") for (int k = 0; k < 2; ++k) \
        acc[ai][bj][m][n] = __builtin_amdgcn_mfma_f32_16x16x32_bf16(Bt[n][k], At[m][k], acc[ai][bj][m][n], 0, 0, 0); __builtin_amdgcn_s_setprio(0); } while (0)
#define PG8_WAIT_V(n) asm volatile("s_waitcnt vmcnt(" #n ")" ::: "memory")
#define PG8_WAIT_L(n) asm volatile("s_waitcnt lgkmcnt(" #n ")" ::: "memory")
#define PG8_BAR __builtin_amdgcn_s_barrier()
#define PG8_SCHED __builtin_amdgcn_sched_barrier(0)
    Unit cur, nxt; int ui = 0;
    if (!S.next(0, cur)) return;
    f32x4 acc[2][2][4][2];
#pragma unroll
    for (int a = 0; a < 2; ++a)
#pragma unroll
        for (int b = 0; b < 2; ++b)
#pragma unroll
            for (int m = 0; m < 4; ++m)
#pragma unroll
                for (int n = 0; n < 2; ++n) acc[a][b][m][n] = (f32x4){0.f, 0.f, 0.f, 0.f};
    bf16x8 At[4][2], B0[2][2], B1[2][2];
    const char* cA = (const char*)g.A + (size_t)cur.pm * tstep; const char* cB = (const char*)g.Bt + (size_t)cur.pn * tstep;
    S.a_ready(cur);
    if constexpr (SP2) {
        PG8_STAGE(PG8_SB(0, 0), cB, voffB); PG8_STAGE(PG8_SB(0, 1), cB + hstep, voffB); PG8_STAGE(PG8_SA(0, 0), cA, voffA); PG8_STAGE(PG8_SA(0, 1), cA + hstep, voffA);
        if (wr == 1) PG8_BAR;
        PG8_WAIT_V(2); PG8_BAR;
        PG8_STAGE(PG8_SB(1, 0), cB + kstep, voffB); PG8_STAGE(PG8_SA(1, 0), cA + kstep, voffA); PG8_STAGE(PG8_SB(1, 1), cB + hstep + kstep, voffB);
        PG8_WAIT_V(6); PG8_BAR;
    } else {
        PG8_STAGE(PG8_SB(0, 0), cB, voffB); PG8_STAGE(PG8_SA(0, 0), cA, voffA); PG8_STAGE(PG8_SB(0, 1), cB + hstep, voffB); PG8_STAGE(PG8_SA(0, 1), cA + hstep, voffA);
        if (wr == 1) PG8_BAR;
        PG8_WAIT_V(4); PG8_BAR;
        PG8_STAGE(PG8_SB(1, 0), cB + kstep, voffB); PG8_STAGE(PG8_SA(1, 0), cA + kstep, voffA); PG8_STAGE(PG8_SB(1, 1), cB + hstep + kstep, voffB);
        PG8_WAIT_V(6); PG8_BAR;
    }
    for (;;) {
        const bool has_next = S.next(ui + 1, nxt);
        const char* nA = has_next ? (const char*)g.A + (size_t)nxt.pm * tstep : cA; const char* nB = has_next ? (const char*)g.Bt + (size_t)nxt.pn * tstep : cB;
        for (int t = 0; t < nt; t += 2) {
            const bool last = (t == nt - 2);
            const char* a1 = cA + (size_t)(t + 1) * kstep;
            const char* a2 = last ? nA : cA + (size_t)(t + 2) * kstep; const char* b2 = last ? nB : cB + (size_t)(t + 2) * kstep;
            const char* a3 = a2 + kstep; const char* b3 = b2 + kstep;
            if (last && has_next) S.a_ready(nxt);
            if constexpr (SP2) {
            PG8_LDB(B0, 0, 0); PG8_LDB(B1, 0, 1); PG8_SCHED; PG8_LDA(At, 0, 0); PG8_STAGE(PG8_SA(1, 1), a1 + hstep, voffA);
            PG8_WAIT_V(8); PG8_WAIT_L(0); PG8_BAR; PG8_MMA(0, 0, At, B0); PG8_MMA(0, 1, At, B1); PG8_BAR; PG8_SCHED;
            PG8_LDA(At, 0, 1); PG8_STAGE(PG8_SB(0, 0), b2, voffB); PG8_STAGE(PG8_SB(0, 1), b2 + hstep, voffB); PG8_STAGE(PG8_SA(0, 0), a2, voffA);
            PG8_WAIT_V(8); PG8_WAIT_L(0); PG8_BAR; PG8_MMA(1, 0, At, B0); PG8_MMA(1, 1, At, B1); PG8_BAR; PG8_SCHED;
            PG8_LDB(B0, 1, 0); PG8_LDB(B1, 1, 1); PG8_SCHED; PG8_LDA(At, 1, 0); PG8_STAGE(PG8_SA(0, 1), a2 + hstep, voffA);
            PG8_WAIT_V(8); PG8_WAIT_L(0); PG8_BAR; PG8_MMA(0, 0, At, B0); PG8_MMA(0, 1, At, B1); PG8_BAR; PG8_SCHED;
            PG8_LDA(At, 1, 1); PG8_STAGE(PG8_SB(1, 0), b3, voffB); PG8_STAGE(PG8_SB(1, 1), b3 + hstep, voffB); PG8_STAGE(PG8_SA(1, 0), a3, voffA);
            PG8_WAIT_V(8); PG8_WAIT_L(0); PG8_BAR; PG8_MMA(1, 0, At, B0); PG8_MMA(1, 1, At, B1); PG8_BAR; PG8_SCHED;
            } else {
            PG8_LDB(B0, 0, 0); PG8_SCHED; PG8_LDA(At, 0, 0); PG8_STAGE(PG8_SA(1, 1), a1 + hstep, voffA);
            PG8_WAIT_L(8); PG8_BAR; PG8_WAIT_L(0); PG8_MMA(0, 0, At, B0); PG8_BAR; PG8_SCHED;
            PG8_LDB(B1, 0, 1); PG8_STAGE(PG8_SB(0, 0), b2, voffB);
            PG8_BAR; PG8_WAIT_L(0); PG8_MMA(0, 1, At, B1); PG8_BAR;
            PG8_LDA(At, 0, 1); PG8_STAGE(PG8_SA(0, 0), a2, voffA);
            PG8_BAR; PG8_WAIT_L(0); PG8_MMA(1, 0, At, B0); PG8_BAR; PG8_SCHED;
            PG8_STAGE(PG8_SB(0, 1), b2 + hstep, voffB);
            PG8_WAIT_V(6); PG8_BAR; PG8_MMA(1, 1, At, B1); PG8_BAR;
            PG8_LDB(B0, 1, 0); PG8_SCHED; PG8_LDA(At, 1, 0); PG8_STAGE(PG8_SA(0, 1), a2 + hstep, voffA);
            PG8_WAIT_L(8); PG8_BAR; PG8_WAIT_L(0); PG8_MMA(0, 0, At, B0); PG8_BAR; PG8_SCHED;
            PG8_LDB(B1, 1, 1); PG8_STAGE(PG8_SB(1, 0), b3, voffB);
            PG8_BAR; PG8_WAIT_L(0); PG8_MMA(0, 1, At, B1); PG8_BAR;
            PG8_LDA(At, 1, 1); PG8_STAGE(PG8_SA(1, 0), a3, voffA);
            PG8_BAR; PG8_WAIT_L(0); PG8_MMA(1, 0, At, B0); PG8_BAR; PG8_SCHED;
            PG8_STAGE(PG8_SB(1, 1), b3 + hstep, voffB);
            PG8_WAIT_V(6); PG8_BAR; PG8_MMA(1, 1, At, B1); PG8_BAR;
            }
        }
        if constexpr (ALIGN_EPI) { if (wr == 0) PG8_BAR; }
        if constexpr (!Epi::AFTER_DRAIN) { E(acc, cur, wr, wc, fr, fq); S.done(cur); }
        if (!has_next) break;
#pragma unroll
        for (int a = 0; a < 2; ++a)
#pragma unroll
            for (int b = 0; b < 2; ++b)
#pragma unroll
                for (int m = 0; m < 4; ++m)
#pragma unroll
                    for (int n = 0; n < 2; ++n) acc[a][b][m][n] = (f32x4){0.f, 0.f, 0.f, 0.f};
        cur = nxt; cA = nA; cB = nB; ++ui;
        if constexpr (ALIGN_EPI) { if (wr == 1) PG8_BAR; }
    }
    PG8_WAIT_V(0);
    if constexpr (!ALIGN_EPI) { if (wr == 0) PG8_BAR; }
    PG8_BAR;
    if constexpr (Epi::AFTER_DRAIN) { E.fused(acc, cur, wr, wc, fr, fq, lds, wid, lane); S.done(cur); }
#undef PG8_SA
#undef PG8_SB
#undef PG8_STAGE
#undef PG8_LDA
#undef PG8_LDB
#undef PG8_MMA
#undef PG8_WAIT_V
#undef PG8_WAIT_L
#undef PG8_BAR
#undef PG8_SCHED
}
}
constexpr int NWAVES = 8;
constexpr size_t MiB = 1u << 20;
constexpr size_t WS_CTL = 0, CTL_ZERO_BYTES = 1 * MiB;
constexpr size_t WS_STATS = 1 * MiB;
constexpr size_t WS_INVN = 1 * MiB + 512 * 1024;
constexpr size_t WS_WIN = 3 * MiB;
constexpr size_t WS_WUPA = WS_WIN + 10 * MiB + 512 * 1024;
constexpr size_t WS_WUPB = WS_WUPA + 1 * MiB;
constexpr size_t WS_WOUT = WS_WUPB + 1 * MiB;
constexpr size_t WS_WGU = WS_WOUT + 2 * MiB;
constexpr size_t WS_WDN = WS_WGU + 11 * MiB;
constexpr size_t WS_B2 = WS_WDN + 5 * MiB + 512 * 1024;
constexpr size_t WS_Q = 35 * MiB;
constexpr size_t WS_HN = 131 * MiB;
constexpr size_t WS_RR = 131 * MiB, WS_KK = 163 * MiB, WS_VV = 195 * MiB;
constexpr size_t WS_RW = 227 * MiB;
constexpr size_t WS_DEC = 227 * MiB, WS_AA = 291 * MiB;
constexpr size_t WS_A2 = 339 * MiB;
constexpr size_t WS_YB = 323 * MiB;
constexpr size_t WS_GG = 355 * MiB;
constexpr size_t WS_O = 387 * MiB;
constexpr size_t WS_T = 131 * MiB;
constexpr size_t WS_H1B = 195 * MiB;
constexpr size_t WS_ACT = 259 * MiB;
constexpr size_t WS_END = 451 * MiB;
static_assert(WS_B2 + 1536 * 256 * 2 <= WS_Q, "weights fit");
constexpr int CW_TMO = 0, CW_CODE = 1, CW_BAR = 4096;
constexpr int RING_OFF = 0, RING_BYTES = 131072;
constexpr int LDSCTL_OFF = RING_BYTES, MISC_OFF = LDSCTL_OFF + 320;
constexpr int LDS_BYTES = 147456;

#define GAS __attribute__((address_space(1)))
#define LAS __attribute__((address_space(3)))
typedef unsigned short bf16;
typedef unsigned v4u __attribute__((ext_vector_type(4)));
typedef float f32x4 __attribute__((ext_vector_type(4)));
typedef short bf16x8 __attribute__((ext_vector_type(8)));
typedef GAS unsigned gu32;
typedef GAS unsigned long long gu64;
#define RLX_AGENT __ATOMIC_RELAXED, __HIP_MEMORY_SCOPE_AGENT
#define LDS_WAIT() asm volatile("s_waitcnt lgkmcnt(0)" ::: "memory")
#define VM_WAIT() asm volatile("s_waitcnt vmcnt(0)" ::: "memory")
__device__ __forceinline__ unsigned long long rt() { return __builtin_amdgcn_s_memrealtime(); }
__device__ __forceinline__ unsigned f2bf(float f) { unsigned u = __builtin_bit_cast(unsigned, f); return (u + 0x7fffu + ((u >> 16) & 1u)) >> 16; }
__device__ __forceinline__ unsigned pk2(float lo, float hi) { return f2bf(lo) | (f2bf(hi) << 16); }

#define XB_TMO      128
#define XB_XCNT(j)  (256  + 64 * (j))
#define XB_XSUB(j)  (1280 + 64 * (j))
#define XB_XGEN(j)  (2304 + 64 * (j))
#define XB_TOP      3328
#define XB_TOPGEN   3392
#define XCD_BAR_WORDS 3456
#define XB_SPIN_CAP (1u << 18)

__device__ __forceinline__ unsigned xb_ld(unsigned* p)              { return __hip_atomic_load(p, __ATOMIC_RELAXED, __HIP_MEMORY_SCOPE_AGENT); }
__device__ __forceinline__ unsigned xb_add(unsigned* p, unsigned v) { return __hip_atomic_fetch_add(p, v, __ATOMIC_RELAXED, __HIP_MEMORY_SCOPE_AGENT); }
__device__ __forceinline__ unsigned xb_xcc_id() { return (unsigned)__builtin_amdgcn_s_getreg((3 << 11) | 20) & 0xFu; }
#define XB_SPIN(cond, bar) do { unsigned _sp = 0; while (cond) { __builtin_amdgcn_s_sleep(1); \
    if ((++_sp & 255u) == 0u) { if (xb_ld(&(bar)[XB_TMO])) break; if (_sp > XB_SPIN_CAP) { atomicAdd(&(bar)[XB_TMO], 1u); break; } } } } while (0)

struct XcdBarrier {
    unsigned* bar; unsigned x;
    volatile LAS unsigned* st;
};

__device__ __forceinline__ XcdBarrier xcd_barrier_post(unsigned* bar, volatile LAS unsigned* st) {
    XcdBarrier b; b.bar = bar; b.x = xb_xcc_id(); b.st = st;
    if (threadIdx.x == 0) (void)xb_add(&bar[XB_XCNT(b.x)], 1u);
    return b;
}
__device__ __forceinline__ void xcd_barrier_complete(unsigned* bar, unsigned x, unsigned& nloc, unsigned& nx) {
    const unsigned G = gridDim.x * gridDim.y * gridDim.z;
    unsigned sum, cnt, mine, sp = 0u;
    for (;;) {
        sum = 0u; cnt = 0u; mine = 0u;
#pragma unroll
        for (unsigned j = 0; j < 16; ++j) { const unsigned c = xb_ld(&bar[XB_XCNT(j)]); sum += c; cnt += (c > 0u) ? 1u : 0u; mine = (j == x) ? c : mine; }
        if (sum == G) break;
        __builtin_amdgcn_s_sleep(1);
        if ((++sp & 255u) == 0u) { if (xb_ld(&bar[XB_TMO])) break; if (sp > XB_SPIN_CAP) { atomicAdd(&bar[XB_TMO], 1u); break; } }
    }
    nloc = mine > 0u ? mine : 1u; nx = cnt > 0u ? cnt : 1u;
}

__device__ __forceinline__ void xcd_barrier(const XcdBarrier& b) {
    asm volatile("s_waitcnt vmcnt(0)" ::: "memory");
    __syncthreads();
    if (threadIdx.x == 0) {
        unsigned* bar = b.bar;
        __builtin_amdgcn_s_waitcnt(0);
        unsigned nloc = b.st[0], nx = b.st[1];
        if (nloc == 0u) { xcd_barrier_complete(bar, b.x, nloc, nx); b.st[0] = nloc; b.st[1] = nx; }
        const unsigned old = xb_add(&bar[XB_XSUB(b.x)], 1u);
        const unsigned gen = old / nloc;
        if (old + 1u == (gen + 1u) * nloc) {
            __builtin_amdgcn_fence(__ATOMIC_RELEASE, "agent");
            asm volatile("s_waitcnt vmcnt(0)" ::: "memory");
            const unsigned og = xb_add(&bar[XB_TOP], 1u);
            const unsigned tg = og / nx;
            if (og + 1u == (tg + 1u) * nx) xb_add(&bar[XB_TOPGEN], 1u);
            else XB_SPIN(xb_ld(&bar[XB_TOPGEN]) == tg, bar);
            __builtin_amdgcn_fence(__ATOMIC_ACQUIRE, "agent");
            xb_add(&bar[XB_XGEN(b.x)], 1u);
            asm volatile("s_waitcnt vmcnt(0)" ::: "memory");
        } else {
            XB_SPIN(xb_ld(&bar[XB_XGEN(b.x)]) == gen, bar);
            __builtin_amdgcn_fence(__ATOMIC_ACQUIRE, "agent");
            asm volatile("s_waitcnt vmcnt(0)" ::: "memory");
        }
    }
    __syncthreads();
}
struct Args { const float* in[31]; float* out; unsigned char* ws; int ph_lo, ph_hi; };
struct Frame {
    LAS unsigned char* lds; volatile LAS unsigned* MISC; gu32* ctl;
    int tid, lane, wave, vcu, G;
};
__device__ __forceinline__ float wave_sum(float v) {
#pragma unroll
    for (int o = 1; o < 64; o <<= 1) v += __shfl_xor(v, o);
    return v;
}
using pg8::bf_lo; using pg8::bf_hi;

__device__ __forceinline__ void p0_transpose_item(const float* W, int ldw, bf16* WT, int Kd, int drow, int k0, int n0, LAS float* scr, int lane) {
#pragma unroll 8
    for (int i = 0; i < 32; ++i) { const int kk = 2 * i + (lane >> 5); scr[kk * 33 + (lane & 31)] = W[(size_t)(k0 + kk) * ldw + n0 + (lane & 31)]; }
    LDS_WAIT(); asm volatile("" ::: "memory");
    const int c = lane & 7;
#pragma unroll
    for (int j = 0; j < 4; ++j) { const int n = (lane >> 3) + 8 * j; const LAS float* s = scr + (8 * c) * 33 + n;
        v4u o; o.x = pk2(s[0 * 33], s[1 * 33]); o.y = pk2(s[2 * 33], s[3 * 33]); o.z = pk2(s[4 * 33], s[5 * 33]); o.w = pk2(s[6 * 33], s[7 * 33]);
        *(GAS v4u*)(WT + (size_t)(drow + n) * Kd + k0 + 8 * c) = o; }
    LDS_WAIT(); asm volatile("" ::: "memory");
}
__device__ __forceinline__ void ln_row(const float* xrow, const float* g, const float* b, float* of32, bf16* obf, float* stat, int lane) {
    const f32x4* xr = (const f32x4*)xrow + lane;
    f32x4 v[4]; float s = 0.f;
#pragma unroll
    for (int j = 0; j < 4; ++j) { v[j] = xr[64 * j]; s += (v[j].x + v[j].y) + (v[j].z + v[j].w); }
    const float mean = wave_sum(s) * (1.f / DM); float s2 = 0.f;
#pragma unroll
    for (int j = 0; j < 4; ++j) { v[j] = v[j] - mean; s2 += (v[j].x * v[j].x + v[j].y * v[j].y) + (v[j].z * v[j].z + v[j].w * v[j].w); }
    const float rstd = 1.f / sqrtf(wave_sum(s2) * (1.f / DM) + LN_EPS);
    if (stat && lane == 0) { stat[0] = mean; stat[1] = rstd; }
#pragma unroll
    for (int j = 0; j < 4; ++j) { const f32x4 gg = ((const f32x4*)g)[lane + 64 * j], bb = ((const f32x4*)b)[lane + 64 * j]; const f32x4 y = v[j] * rstd * gg + bb;
        if (of32) ((f32x4*)of32)[lane + 64 * j] = y;
        if (obf) ((unsigned long long*)obf)[lane + 64 * j] = (unsigned long long)pk2(y.x, y.y) | ((unsigned long long)pk2(y.z, y.w) << 32); }
}
__device__ __forceinline__ void p0_prologue(Frame& F, const Args& a) {
    unsigned char* ws = a.ws;
    LAS float* scr = (LAS float*)(F.lds + RING_OFF + F.wave * 16384);
    const int gw = F.vcu * NWAVES + F.wave, NGW = F.G * NWAVES;
    constexpr int I_IN = 16 * 168, I_UP = 8 * 32, I_OUT = 16 * 32, I_G = 16 * 88, I_DN = 44 * 32;
    constexpr int NITEMS = I_IN + 2 * I_UP + I_OUT + 2 * I_G + I_DN;
    for (int it = gw; it < NITEMS; it += NGW) {
        int r = it;
        if (r < I_IN) { const int kb = r / 168, nb = r % 168; p0_transpose_item(a.in[4], NPROJ, (bf16*)(ws + WS_WIN), 1024, 32 * nb, 64 * kb, 32 * nb, scr, F.lane); continue; } r -= I_IN;
        if (r < I_UP) { const int kb = r / 32, nb = r % 32; p0_transpose_item(a.in[21], 1024, (bf16*)(ws + WS_WUPA), 512, 32 * nb, 64 * kb, 32 * nb, scr, F.lane); continue; } r -= I_UP;
        if (r < I_UP) { const int kb = r / 32, nb = r % 32; p0_transpose_item(a.in[22], 1024, (bf16*)(ws + WS_WUPB), 512, 32 * nb, 64 * kb, 32 * nb, scr, F.lane); continue; } r -= I_UP;
        if (r < I_OUT) { const int kb = r / 32, nb = r % 32; p0_transpose_item(a.in[23], 1024, (bf16*)(ws + WS_WOUT), 1024, 32 * nb, 64 * kb, 32 * nb, scr, F.lane); continue; } r -= I_OUT;
        if (r < I_G) { const int kb = r / 88, nb = r % 88, n0 = 32 * nb; p0_transpose_item(a.in[26], FFH, (bf16*)(ws + WS_WGU), 1024, 256 * (n0 >> 7) + (n0 & 127), 64 * kb, n0, scr, F.lane); continue; } r -= I_G;
        if (r < I_G) { const int kb = r / 88, nb = r % 88, n0 = 32 * nb; p0_transpose_item(a.in[27], FFH, (bf16*)(ws + WS_WGU), 1024, 256 * (n0 >> 7) + 128 + (n0 & 127), 64 * kb, n0, scr, F.lane); continue; } r -= I_G;
        { const int kb = r / 32, nb = r % 32; p0_transpose_item(a.in[28], 1024, (bf16*)(ws + WS_WDN), FFH, 32 * nb, 64 * kb, 32 * nb, scr, F.lane); }
    }
    { bf16* B2 = (bf16*)(ws + WS_B2); const float* w2 = a.in[12]; const float* a2 = a.in[14]; const float* g2 = a.in[15];
      for (int e = (F.vcu * 512 + F.tid); e < 1536 * 256; e += F.G * 512) { const int n = e >> 8, k = e & 255; float v = 0.f;
          if (n < 512) { if (k < 64) v = w2[k * 512 + n]; }
          else if (n < 1024) { if (k >= 64 && k < 128) v = a2[(k - 64) * 512 + (n - 512)]; }
          else { if (k >= 128) v = g2[(k - 128) * 512 + (n - 1024)]; }
          B2[e] = (bf16)(pk2(v, 0.f) & 0xffffu); } }
    for (int m = gw; m < MTOK; m += NGW) ln_row(a.in[0] + (size_t)m * DM, a.in[1], a.in[2], nullptr, (bf16*)(ws + WS_HN) + (size_t)m * DM, (float*)(ws + WS_STATS) + 2 * m, F.lane);
}
__device__ __forceinline__ void p2a_shift(Frame& F, const Args& a) {
    unsigned char* ws = a.ws;
    const bf16* RW = (const bf16*)(ws + WS_RW); const float* mu = a.in[10]; const float* k_k = a.in[16];
    bf16* RR = (bf16*)(ws + WS_RR); bf16* KK = (bf16*)(ws + WS_KK); bf16* VV = (bf16*)(ws + WS_VV); bf16* A2 = (bf16*)(ws + WS_A2); float* INV = (float*)(ws + WS_INVN);
    const int gw = F.vcu * NWAVES + F.wave, NGW = F.G * NWAVES, lane = F.lane;
    for (int m = gw; m < MTOK; m += NGW) {
        const bool first = (m & (SEQ - 1)) == 0;
#pragma unroll
        for (int it = 0; it < 4; ++it) {
            const int c0 = lane * 8 + it * 512;
            if (it < 3 || lane < 32) {
                const v4u cur = *(const v4u*)(RW + (size_t)m * 1792 + c0);
                v4u prv = (v4u){0u, 0u, 0u, 0u}; if (!first) prv = *(const v4u*)(RW + (size_t)(m - 1) * 1792 + c0);
                const f32x4 m0 = *(const f32x4*)(mu + c0), m1 = *(const f32x4*)(mu + c0 + 4);
                float xs[8];
                { const unsigned cw[4] = {cur.x, cur.y, cur.z, cur.w}, pw[4] = {prv.x, prv.y, prv.z, prv.w}; const float mm[8] = {m0.x, m0.y, m0.z, m0.w, m1.x, m1.y, m1.z, m1.w};
#pragma unroll
                  for (int e = 0; e < 4; ++e) { const float c_lo = bf_lo(cw[e]), c_hi = bf_hi(cw[e]), p_lo = bf_lo(pw[e]), p_hi = bf_hi(pw[e]);
                      xs[2 * e] = c_lo + (p_lo - c_lo) * mm[2 * e]; xs[2 * e + 1] = c_hi + (p_hi - c_hi) * mm[2 * e + 1]; } }
                if (it == 3) {
                    const int cl = lane * 8;
#pragma unroll
                    for (int e = 0; e < 8; ++e) { if (cl < 64) xs[e] = tanhf(xs[e]); else if (cl >= 128) xs[e] = 1.0f / (1.0f + expf(-xs[e])); }
                    v4u o; o.x = pk2(xs[0], xs[1]); o.y = pk2(xs[2], xs[3]); o.z = pk2(xs[4], xs[5]); o.w = pk2(xs[6], xs[7]);
                    *(v4u*)(A2 + (size_t)m * 256 + cl) = o;
                } else {
                    v4u o; o.x = pk2(xs[0], xs[1]); o.y = pk2(xs[2], xs[3]); o.z = pk2(xs[4], xs[5]); o.w = pk2(xs[6], xs[7]);
                    const int cc = lane * 8;
                    bf16* dst = (it == 0) ? RR : (it == 1) ? KK : VV;
                    *(v4u*)(dst + (size_t)m * 512 + cc) = o;
                    if (it == 1) {
                        const f32x4 k0 = *(const f32x4*)(k_k + cc), k1 = *(const f32x4*)(k_k + cc + 4);
                        const float kq[8] = {k0.x, k0.y, k0.z, k0.w, k1.x, k1.y, k1.z, k1.w}; const unsigned ow[4] = {o.x, o.y, o.z, o.w};
                        float ss = 0.f;
#pragma unroll
                        for (int e = 0; e < 4; ++e) { const float a0 = bf_lo(ow[e]) * kq[2 * e], a1 = bf_hi(ow[e]) * kq[2 * e + 1]; ss += a0 * a0 + a1 * a1; }
                        ss += __shfl_xor(ss, 1); ss += __shfl_xor(ss, 2); ss += __shfl_xor(ss, 4);
                        if ((lane & 7) == 0) INV[(size_t)m * 8 + (lane >> 3)] = 1.0f / sqrtf(fmaxf(ss, 1e-24f));
                    }
                }
            }
        }
    }
}
__device__ __forceinline__ int t5_bucket(int d) {
    if (d < 16) return d;
    int b = 16;
    b += (d >= 19); b += (d >= 21); b += (d >= 24); b += (d >= 27); b += (d >= 31); b += (d >= 35); b += (d >= 40); b += (d >= 46);
    b += (d >= 52); b += (d >= 59); b += (d >= 67); b += (d >= 77); b += (d >= 87); b += (d >= 99); b += (d >= 113);
    return b;
}
__device__ __forceinline__ float diff_lambda(const Args& a) {
    float s1 = 0.f, s2 = 0.f;
    for (int i = 0; i < 64; ++i) { s1 += a.in[5][i] * a.in[6][i]; s2 += a.in[7][i] * a.in[8][i]; }
    return expf(s1) - expf(s2) + 0.2f;
}
__device__ __forceinline__ void attn_naive(Frame& F, const Args& a) {
    unsigned char* ws = a.ws;
    const bf16* Q = (const bf16*)(ws + WS_Q); const bf16* K = Q + (size_t)MTOK * 512; const bf16* V = K + (size_t)MTOK * 512; bf16* O = (bf16*)(ws + WS_O);
    LAS float* btab = (LAS float*)(F.lds + RING_OFF);
    for (int e = F.tid; e < 512; e += 512) { const int h = e >> 7, d = e & 127; btab[e] = (a.in[3][t5_bucket(d) * 4 + h] - a.in[3][31 * 4 + h]) * LOG2E; }
    __syncthreads();
    const int blk = F.vcu;
    for (int i = 0; i < 4; ++i) {
        const int qc = i, b = blk >> 4, hcv = blk & 15, hc = hcv >> 1, vh = hcv & 1, h = hc >> 1;
        const int qpos = qc * 512 + F.tid; const size_t row = (size_t)b * SEQ + qpos;
        float q[64], o[64];
#pragma unroll
        for (int d8 = 0; d8 < 8; ++d8) { const v4u w = *(const v4u*)(Q + row * 512 + hc * 64 + d8 * 8);
            q[d8 * 8 + 0] = bf_lo(w.x); q[d8 * 8 + 1] = bf_hi(w.x); q[d8 * 8 + 2] = bf_lo(w.y); q[d8 * 8 + 3] = bf_hi(w.y);
            q[d8 * 8 + 4] = bf_lo(w.z); q[d8 * 8 + 5] = bf_hi(w.z); q[d8 * 8 + 6] = bf_lo(w.w); q[d8 * 8 + 7] = bf_hi(w.w); }
#pragma unroll
        for (int d = 0; d < 64; ++d) o[d] = 0.f;
        float mx = -1e30f, l = 0.f;
        const bf16* Kp = K + (size_t)b * SEQ * 512 + hc * 64; const bf16* Vp = V + (size_t)b * SEQ * 512 + h * 128 + vh * 64;
        const int jend = qc * 512 + (F.tid | 63);
        for (int j = 0; j <= jend; ++j) {
            float s = 0.f;
#pragma unroll
            for (int d8 = 0; d8 < 8; ++d8) { const v4u w = *(const v4u*)(Kp + (size_t)j * 512 + d8 * 8);
                s += q[d8 * 8 + 0] * bf_lo(w.x) + q[d8 * 8 + 1] * bf_hi(w.x) + q[d8 * 8 + 2] * bf_lo(w.y) + q[d8 * 8 + 3] * bf_hi(w.y)
                   + q[d8 * 8 + 4] * bf_lo(w.z) + q[d8 * 8 + 5] * bf_hi(w.z) + q[d8 * 8 + 6] * bf_lo(w.w) + q[d8 * 8 + 7] * bf_hi(w.w); }
            const int dist = qpos - j;
            if (dist >= 0) {
                s += btab[h * 128 + (dist < 127 ? dist : 127)];
                const float mn = fmaxf(mx, s), al = __builtin_amdgcn_exp2f(mx - mn), p = __builtin_amdgcn_exp2f(s - mn);
                l = l * al + p; mx = mn;
#pragma unroll
                for (int d8 = 0; d8 < 8; ++d8) { const v4u w = *(const v4u*)(Vp + (size_t)j * 512 + d8 * 8);
                    o[d8 * 8 + 0] = o[d8 * 8 + 0] * al + p * bf_lo(w.x); o[d8 * 8 + 1] = o[d8 * 8 + 1] * al + p * bf_hi(w.x);
                    o[d8 * 8 + 2] = o[d8 * 8 + 2] * al + p * bf_lo(w.y); o[d8 * 8 + 3] = o[d8 * 8 + 3] * al + p * bf_hi(w.y);
                    o[d8 * 8 + 4] = o[d8 * 8 + 4] * al + p * bf_lo(w.z); o[d8 * 8 + 5] = o[d8 * 8 + 5] * al + p * bf_hi(w.z);
                    o[d8 * 8 + 6] = o[d8 * 8 + 6] * al + p * bf_lo(w.w); o[d8 * 8 + 7] = o[d8 * 8 + 7] * al + p * bf_hi(w.w); }
            }
        }
        const float rl = 1.0f / l;
#pragma unroll
        for (int d8 = 0; d8 < 8; ++d8) { v4u w; w.x = pk2(o[d8 * 8 + 0] * rl, o[d8 * 8 + 1] * rl); w.y = pk2(o[d8 * 8 + 2] * rl, o[d8 * 8 + 3] * rl);
            w.z = pk2(o[d8 * 8 + 4] * rl, o[d8 * 8 + 5] * rl); w.w = pk2(o[d8 * 8 + 6] * rl, o[d8 * 8 + 7] * rl);
            *(v4u*)(O + row * 1024 + hc * 128 + vh * 64 + d8 * 8) = w; }
    }
    __syncthreads();
}
constexpr int SC_TC = 32;
__device__ __forceinline__ void scan_phase(Frame& F, const Args& a) {
    unsigned char* ws = a.ws;
    const bf16* RR = (const bf16*)(ws + WS_RR); const bf16* KK = (const bf16*)(ws + WS_KK); const bf16* VV = (const bf16*)(ws + WS_VV);
    const float* DEC = (const float*)(ws + WS_DEC); const bf16* AA = (const bf16*)(ws + WS_AA); const bf16* GG = (const bf16*)(ws + WS_GG); const float* INV = (const float*)(ws + WS_INVN);
    bf16* YB = (bf16*)(ws + WS_YB);
    const float* k_k = a.in[16]; const float* k_a = a.in[17]; const float* r_k = a.in[18]; const float* lnx_g = a.in[19]; const float* lnx_b = a.in[20];
    LAS float* L = (LAS float*)(F.lds + RING_OFF);
    LAS float* Ldec = L, *Lkk = L + SC_TC * 64, *Lbet = L + 2 * SC_TC * 64, *Lkp = L + 3 * SC_TC * 64, *Lr = L + 4 * SC_TC * 64, *Lv = L + 5 * SC_TC * 64, *Ly = L + 6 * SC_TC * 64;
    const int tid = F.tid, row = tid >> 3, jg = tid & 7;
    for (int bh = F.vcu; bh < NBATCH * 8; bh += F.G) {
        const int b = bh >> 3, h = bh & 7;
        float S[8];
#pragma unroll
        for (int e = 0; e < 8; ++e) S[e] = 0.f;
        for (int c0 = 0; c0 < SEQ; c0 += SC_TC) {
#pragma unroll
            for (int q = 0; q < 4; ++q) { const int e = tid + 512 * q, tt = e >> 6, j = e & 63; const size_t m = (size_t)b * SEQ + c0 + tt; const int col = h * 64 + j; const size_t off = m * 512 + col;
                const float rv = bf_lo((unsigned)RR[off]), kv = bf_lo((unsigned)KK[off]), vv = bf_lo((unsigned)VV[off]), av = bf_lo((unsigned)AA[off]);
                const float kkv = kv * k_k[col] * INV[m * 8 + h];
                Ldec[e] = DEC[off]; Lkk[e] = kkv; Lbet[e] = kkv * av; Lkp[e] = kv * (1.0f + (av - 1.0f) * k_a[col]); Lr[e] = rv; Lv[e] = vv; }
            __syncthreads();
            for (int tt = 0; tt < SC_TC; ++tt) {
                const LAS f32x4* pk = (const LAS f32x4*)(Lkk + tt * 64 + jg * 8); const f32x4 k0 = pk[0], k1 = pk[1];
                float sa = S[0] * k0.x + S[1] * k0.y + S[2] * k0.z + S[3] * k0.w + S[4] * k1.x + S[5] * k1.y + S[6] * k1.z + S[7] * k1.w;
                sa += __shfl_xor(sa, 1); sa += __shfl_xor(sa, 2); sa += __shfl_xor(sa, 4); sa = -sa;
                const float vr = Lv[tt * 64 + row];
                const LAS f32x4* pd = (const LAS f32x4*)(Ldec + tt * 64 + jg * 8); const f32x4 d0 = pd[0], d1 = pd[1];
                const LAS f32x4* pb = (const LAS f32x4*)(Lbet + tt * 64 + jg * 8); const f32x4 b0 = pb[0], b1 = pb[1];
                const LAS f32x4* pp = (const LAS f32x4*)(Lkp + tt * 64 + jg * 8); const f32x4 p0 = pp[0], p1 = pp[1];
                S[0] = S[0] * d0.x + sa * b0.x + vr * p0.x; S[1] = S[1] * d0.y + sa * b0.y + vr * p0.y; S[2] = S[2] * d0.z + sa * b0.z + vr * p0.z; S[3] = S[3] * d0.w + sa * b0.w + vr * p0.w;
                S[4] = S[4] * d1.x + sa * b1.x + vr * p1.x; S[5] = S[5] * d1.y + sa * b1.y + vr * p1.y; S[6] = S[6] * d1.z + sa * b1.z + vr * p1.z; S[7] = S[7] * d1.w + sa * b1.w + vr * p1.w;
                const LAS f32x4* pr = (const LAS f32x4*)(Lr + tt * 64 + jg * 8); const f32x4 r0 = pr[0], r1 = pr[1];
                float y = S[0] * r0.x + S[1] * r0.y + S[2] * r0.z + S[3] * r0.w + S[4] * r1.x + S[5] * r1.y + S[6] * r1.z + S[7] * r1.w;
                y += __shfl_xor(y, 1); y += __shfl_xor(y, 2); y += __shfl_xor(y, 4);
                if (jg == 0) Ly[tt * 64 + row] = y;
            }
            __syncthreads();
            { const int tt = tid >> 4, part = tid & 15, j0 = part * 4; const size_t m = (size_t)b * SEQ + c0 + tt; const int col = h * 64 + j0;
              const f32x4 y4 = *(const LAS f32x4*)(Ly + tt * 64 + j0);
              float s = (y4.x + y4.y) + (y4.z + y4.w); s += __shfl_xor(s, 1); s += __shfl_xor(s, 2); s += __shfl_xor(s, 4); s += __shfl_xor(s, 8);
              const float mean = s * (1.0f / 64.0f); const f32x4 dd = y4 - mean;
              float q2 = (dd.x * dd.x + dd.y * dd.y) + (dd.z * dd.z + dd.w * dd.w); q2 += __shfl_xor(q2, 1); q2 += __shfl_xor(q2, 2); q2 += __shfl_xor(q2, 4); q2 += __shfl_xor(q2, 8);
              const float rstd = 1.0f / sqrtf(q2 * (1.0f / 64.0f) + LNX_EPS);
              const f32x4 r4 = *(const LAS f32x4*)(Lr + tt * 64 + j0), kp4 = *(const LAS f32x4*)(Lkp + tt * 64 + j0), v4 = *(const LAS f32x4*)(Lv + tt * 64 + j0);
              const f32x4 rk4 = *(const f32x4*)(r_k + col);
              float bs = (r4.x * kp4.x * rk4.x + r4.y * kp4.y * rk4.y) + (r4.z * kp4.z * rk4.z + r4.w * kp4.w * rk4.w);
              bs += __shfl_xor(bs, 1); bs += __shfl_xor(bs, 2); bs += __shfl_xor(bs, 4); bs += __shfl_xor(bs, 8);
              const f32x4 lg = *(const f32x4*)(lnx_g + col), lb = *(const f32x4*)(lnx_b + col);
              const pg8::u32x2 gw = *(const pg8::u32x2*)(GG + m * 512 + col);
              f32x4 ov = dd * rstd * lg + lb + v4 * bs;
              ov.x *= bf_lo(gw.x); ov.y *= bf_hi(gw.x); ov.z *= bf_lo(gw.y); ov.w *= bf_hi(gw.y);
              pg8::u32x2 w; w.x = pk2(ov.x, ov.y); w.y = pk2(ov.z, ov.w);
              *(pg8::u32x2*)(YB + m * 512 + col) = w; }
            __syncthreads();
        }
    }
}
__device__ __forceinline__ void p2d_combine(Frame& F, const Args& a) {
    unsigned char* ws = a.ws;
    const bf16* O = (const bf16*)(ws + WS_O); bf16* YA = (bf16*)(ws + WS_Q); const float* sg = a.in[9];
    const float lam = diff_lambda(a);
    const int gw = F.vcu * NWAVES + F.wave, NGW = F.G * NWAVES, lane = F.lane;
    const int h = lane >> 4, e0 = (lane & 15) * 8;
    const f32x4 g0 = *(const f32x4*)(sg + e0), g1 = *(const f32x4*)(sg + e0 + 4);
    for (int m = gw; m < MTOK; m += NGW) {
        const v4u w0 = *(const v4u*)(O + (size_t)m * 1024 + (h * 2) * 128 + e0), w1 = *(const v4u*)(O + (size_t)m * 1024 + (h * 2 + 1) * 128 + e0);
        float d[8] = { bf_lo(w0.x) - lam * bf_lo(w1.x), bf_hi(w0.x) - lam * bf_hi(w1.x), bf_lo(w0.y) - lam * bf_lo(w1.y), bf_hi(w0.y) - lam * bf_hi(w1.y),
                       bf_lo(w0.z) - lam * bf_lo(w1.z), bf_hi(w0.z) - lam * bf_hi(w1.z), bf_lo(w0.w) - lam * bf_lo(w1.w), bf_hi(w0.w) - lam * bf_hi(w1.w) };
        float ss = 0.f;
#pragma unroll
        for (int e = 0; e < 8; ++e) ss += d[e] * d[e];
        ss += __shfl_xor(ss, 1); ss += __shfl_xor(ss, 2); ss += __shfl_xor(ss, 4); ss += __shfl_xor(ss, 8);
        const float r = 0.8f / sqrtf(ss * (1.0f / 128.0f) + LN_EPS);
        v4u o; o.x = pk2(d[0] * r * g0.x, d[1] * r * g0.y); o.y = pk2(d[2] * r * g0.z, d[3] * r * g0.w); o.z = pk2(d[4] * r * g1.x, d[5] * r * g1.y); o.w = pk2(d[6] * r * g1.z, d[7] * r * g1.w);
        *(v4u*)(YA + (size_t)m * 512 + h * 128 + e0) = o;
    }
}
__device__ __forceinline__ void ln_pass(Frame& F, float* Z, const float* g, const float* b, bf16* obf) {
    const int gw = F.vcu * NWAVES + F.wave, NGW = F.G * NWAVES;
    for (int m = gw; m < MTOK; m += NGW) ln_row(Z + (size_t)m * DM, g, b, Z + (size_t)m * DM, obf ? obf + (size_t)m * DM : nullptr, nullptr, F.lane);
}

constexpr int NPHASE = 12;
__global__ void __launch_bounds__(NWAVES * 64, 2) fwd_kernel(Args args) {
    extern __shared__ __attribute__((aligned(16))) unsigned char lds[];
    Frame F;
    F.lds = (LAS unsigned char*)lds;
    F.MISC = (volatile LAS unsigned*)(F.lds + MISC_OFF);
    F.tid = threadIdx.x; F.lane = F.tid & 63; F.wave = __builtin_amdgcn_readfirstlane(F.tid >> 6);
    F.G = gridDim.x; { const int bx = blockIdx.x; F.vcu = (F.G % 8 == 0) ? (bx % 8) * (F.G / 8) + bx / 8 : bx; }
    unsigned char* ws = args.ws;
    F.ctl = (gu32*)(ws + WS_CTL);
    for (int u = F.tid; u < (LDS_BYTES - LDSCTL_OFF) / 4; u += NWAVES * 64) ((LAS unsigned*)(F.lds + LDSCTL_OFF))[u] = 0u;
    __syncthreads();
#if MK_ONE_LAUNCH
    XcdBarrier bar = xcd_barrier_post((unsigned*)(F.ctl + CW_BAR), F.MISC + 8);
#define GRID_BAR() xcd_barrier(bar)
#else
#define GRID_BAR() do {} while (0)
#endif
    const int lo = args.ph_lo, hi = args.ph_hi;
#define IN(k) (lo <= (k) && (k) < hi)
#define BOTH(k) (IN(k) && IN((k) + 1))
    typedef pg8::bf16_t pb;
    if (IN(0)) { p0_prologue(F, args); if (BOTH(0)) GRID_BAR(); }
    if (IN(1)) {
        pg8::Gemm g{(const pb*)(ws + WS_HN), (const pb*)(ws + WS_WIN), MTOK, NPROJ, DM}; pg8::StaticOrder S; S.init(MTOK, NPROJ, F.G, (int)blockIdx.x);
        pg8::EpiProj E{(pb*)(ws + WS_Q), (pb*)(ws + WS_RW), (pb*)args.out};
        pg8::gemm_phase<pg8::EpiProj, pg8::StaticOrder, true, true>(F.lds + RING_OFF, g, S, E);
        if (BOTH(1)) GRID_BAR();
    }
    if (IN(2)) { p2a_shift(F, args); if (BOTH(2)) GRID_BAR(); }
    if (IN(3)) {
        pg8::Gemm g{(const pb*)(ws + WS_A2), (const pb*)(ws + WS_B2), MTOK, 1536, 256}; pg8::StaticOrder S; S.init(MTOK, 1536, F.G, (int)blockIdx.x);
        pg8::EpiLowrank E{(float*)(ws + WS_DEC), (pb*)(ws + WS_AA), (WS_GG - WS_AA) / 2, args.in[11], args.in[13]};
        pg8::gemm_phase<pg8::EpiLowrank, pg8::StaticOrder, true, true>(F.lds + RING_OFF, g, S, E);
        if (BOTH(3)) GRID_BAR();
    }
    if (IN(4)) { attn_naive(F, args); scan_phase(F, args); if (BOTH(4)) GRID_BAR(); }
    if (IN(5)) { p2d_combine(F, args); if (BOTH(5)) GRID_BAR(); }
    if (IN(6)) {
        { pg8::Gemm g{(const pb*)(ws + WS_Q), (const pb*)(ws + WS_WUPA), MTOK, DM, 512}; pg8::StaticOrder S; S.init(MTOK, DM, F.G, (int)blockIdx.x);
          pg8::EpiUp<0> E{(const pb*)args.out, (pb*)(ws + WS_T)};
          pg8::gemm_phase<pg8::EpiUp<0>, pg8::StaticOrder, true, true>(F.lds + RING_OFF, g, S, E); }
        asm volatile("s_waitcnt vmcnt(0)" ::: "memory"); __syncthreads();
        { pg8::Gemm g{(const pb*)(ws + WS_YB), (const pb*)(ws + WS_WUPB), MTOK, DM, 512}; pg8::StaticOrder S; S.init(MTOK, DM, F.G, (int)blockIdx.x);
          pg8::EpiUp<1> E{(const pb*)args.out, (pb*)(ws + WS_T)};
          pg8::gemm_phase<pg8::EpiUp<1>, pg8::StaticOrder, true, true>(F.lds + RING_OFF, g, S, E); }
        if (BOTH(6)) GRID_BAR();
    }
    if (IN(7)) {
        pg8::Gemm g{(const pb*)(ws + WS_T), (const pb*)(ws + WS_WOUT), MTOK, DM, DM}; pg8::StaticOrder S; S.init(MTOK, DM, F.G, (int)blockIdx.x);
        pg8::EpiOutZ E{args.in[0], (const float*)(ws + WS_STATS), args.in[1], args.in[2], args.out};
        pg8::gemm_phase<pg8::EpiOutZ, pg8::StaticOrder, true, true>(F.lds + RING_OFF, g, S, E);
        if (BOTH(7)) GRID_BAR();
    }
    if (IN(8)) { ln_pass(F, args.out, args.in[24], args.in[25], (bf16*)(ws + WS_H1B)); if (BOTH(8)) GRID_BAR(); }
    if (IN(9)) {
        pg8::Gemm g{(const pb*)(ws + WS_H1B), (const pb*)(ws + WS_WGU), MTOK, 2 * FFH, DM}; pg8::StaticOrder S; S.init(MTOK, 2 * FFH, F.G, (int)blockIdx.x);
        pg8::EpiSwiglu E{(pb*)(ws + WS_ACT)};
        pg8::gemm_phase<pg8::EpiSwiglu, pg8::StaticOrder, true, true>(F.lds + RING_OFF, g, S, E);
        if (BOTH(9)) GRID_BAR();
    }
    if (IN(10)) {
        pg8::Gemm g{(const pb*)(ws + WS_ACT), (const pb*)(ws + WS_WDN), MTOK, DM, FFH}; pg8::StaticOrder S; S.init(MTOK, DM, F.G, (int)blockIdx.x);
        pg8::EpiDownZ E{args.out};
        pg8::gemm_phase<pg8::EpiDownZ, pg8::StaticOrder, true, true>(F.lds + RING_OFF, g, S, E);
        if (BOTH(10)) GRID_BAR();
    }
    if (IN(11)) { ln_pass(F, args.out, args.in[29], args.in[30], nullptr); }
#undef IN
#undef BOTH
}

extern "C" void kernel_launch(void* const* d_in, const int* in_sizes, int n_in, void* d_out, int out_size, void* d_ws, size_t ws_size, hipStream_t stream) {
    static int grid = 0;
    if (grid == 0) {
        if (n_in != 31 || in_sizes[0] != MTOK * DM || out_size != MTOK * DM || ws_size < WS_END) { fprintf(stderr, "kernel_launch: unexpected shapes (n_in %d, in0 %d, out %d, ws %zu); nothing launched\n", n_in, n_in > 0 ? in_sizes[0] : -1, out_size, ws_size); grid = -1; return; }
        int dev = 0, cus = 0, per_cu = 0;
        if (hipGetDevice(&dev) != hipSuccess || hipDeviceGetAttribute(&cus, hipDeviceAttributeMultiprocessorCount, dev) != hipSuccess) { grid = -1; return; }
        if (hipFuncSetAttribute((const void*)fwd_kernel, hipFuncAttributeMaxDynamicSharedMemorySize, LDS_BYTES) != hipSuccess) { fprintf(stderr, "kernel_launch: hipFuncSetAttribute failed\n"); grid = -1; return; }
        if (hipOccupancyMaxActiveBlocksPerMultiprocessor(&per_cu, (const void*)fwd_kernel, NWAVES * 64, LDS_BYTES) != hipSuccess || per_cu < 1) { fprintf(stderr, "kernel_launch: occupancy query reports %d blocks per CU\n", per_cu); per_cu = 1; }
        (void)hipGetLastError();
        grid = cus;
    }
    if (grid < 0) return;
    if (hipMemsetAsync((char*)d_ws + WS_CTL, 0, CTL_ZERO_BYTES, stream) != hipSuccess) return;
    Args a{};
    for (int i = 0; i < 31; ++i) a.in[i] = (const float*)d_in[i];
    a.out = (float*)d_out; a.ws = (unsigned char*)d_ws;
#if MK_ONE_LAUNCH
    a.ph_lo = 0; a.ph_hi = NPHASE;
    hipLaunchKernelGGL(fwd_kernel, dim3(grid), dim3(NWAVES * 64), LDS_BYTES, stream, a);
#else
    for (int p = 0; p < NPHASE; ++p) { a.ph_lo = p; a.ph_hi = p + 1; hipLaunchKernelGGL(fwd_kernel, dim3(grid), dim3(NWAVES * 64), LDS_BYTES, stream, a); }
#endif
}
```

```cpp
#include <hip/hip_runtime.h>
#include <cstdio>
#include <cstdint>
#include <cmath>

#ifndef MK_ONE_LAUNCH
#define MK_ONE_LAUNCH 1
#endif

constexpr int MTOK = 32768, DM = 1024, SEQ = 2048, NBATCH = 16;
constexpr int NPROJ = 5376, FFH = 2816;
constexpr float C2 = 0.125f * 1.4426950408889634f;
constexpr float LOG2E = 1.4426950408889634f;
constexpr float ALPHA = 1.189207115002721f;
constexpr float LN_EPS = 1e-5f, LNX_EPS = 64e-5f;

namespace pg8 {
#define PG8_LAS __attribute__((address_space(3)))
typedef unsigned short bf16_t;
typedef short bf16x8 __attribute__((ext_vector_type(8)));
typedef float f32x4 __attribute__((ext_vector_type(4)));
typedef unsigned u32x4 __attribute__((ext_vector_type(4)));
constexpr int BM = 256, BK = 64, HALF = 128, HTB = HALF * BK * 2  , STAGE_BYTES = 8 * HTB, NXCD = 8, WGM = 8;

__host__ __device__ __forceinline__ int lds_byte(int r, int c) { const int st = (r >> 4) * 2 + (c >> 5), rr = r & 15, cc = c & 31, ob = rr * 64 + cc * 2; return st * 1024 + (ob ^ (((ob >> 9) & 1) << 5)); }
__host__ __device__ __forceinline__ void stage_rc(int b, int& R, int& C) { const int st = b / 1024, sb = b % 1024, swz = sb ^ (((sb >> 9) & 1) << 5); R = (st >> 1) * 16 + swz / 64; C = (st & 1) * 32 + (swz % 64) / 2; }
__host__ __device__ __forceinline__ int perm32(int rho) { const int n = rho >> 4, i = rho & 15; return 8 * (i >> 2) + 4 * n + (i & 3); }

struct Unit { int pm, pn; };
struct Gemm { const bf16_t* A; const bf16_t* Bt; int M, N, K; };

struct StaticOrder {
    int nM, nN, nwg, G, c;
    __host__ __device__ void init(int M, int N, int G_, int c_) { nM = M / BM; nN = N / BM; nwg = nM * nN; G = G_; c = c_; }
    __host__ __device__ bool next(int i, Unit& u) const {
        const long L = (long)i * G + c; if (L >= nwg) return false;
        int wgid = (int)L; { const int q = nwg / NXCD, r = nwg % NXCD, xcd = wgid % NXCD, off = wgid / NXCD; wgid = (xcd < r ? xcd * (q + 1) : r * (q + 1) + (xcd - r) * q) + off; }
        const int nig = WGM * nN, gid = wgid / nig, fm = gid * WGM, gsz = (nM - fm) < WGM ? (nM - fm) : WGM;
        u.pm = fm + ((wgid % nig) % gsz); u.pn = (wgid % nig) / gsz; return true;
    }
    __device__ __forceinline__ void a_ready(const Unit&) const {}
    __device__ __forceinline__ void done(const Unit&) const {}
};

__device__ __forceinline__ unsigned cvt_pk_bf16(float lo, float hi) { unsigned r; asm volatile("v_cvt_pk_bf16_f32 %0, %1, %2" : "=v"(r) : "v"(lo), "v"(hi)); return r; }
__device__ __forceinline__ float bf_lo(unsigned w) { return __builtin_bit_cast(float, w << 16); }
__device__ __forceinline__ float bf_hi(unsigned w) { return __builtin_bit_cast(float, w & 0xffff0000u); }
__device__ __forceinline__ float sigmoid_f(float x) { return __builtin_amdgcn_rcpf(1.0f + __builtin_amdgcn_exp2f(-x * 1.4426950408889634f)); }
typedef unsigned u32x2 __attribute__((ext_vector_type(2)));
struct EpiProj {
    static constexpr bool PERM = true, AFTER_DRAIN = false;
    bf16_t* Q; bf16_t* RW; bf16_t* GT;
    __device__ __forceinline__ void operator()(const f32x4 (&acc)[2][2][4][2], const Unit& u, int wr, int wc, int fr, int fq) const {
        const int row0 = u.pm * BM + wr * 64 + fr; const int colt = u.pn * BM;
        bf16_t* base; int ldc, c0; float sc = 1.f; bool sig = false;
        if (colt < 1536) { const int t = colt >> 9; base = Q + (size_t)t * ((size_t)MTOK * 512); ldc = 512; c0 = colt & 511; if (t == 0) sc = C2; }
        else if (colt < 3328) { base = RW; ldc = 1792; c0 = colt - 1536; }
        else { base = GT; ldc = 2048; c0 = colt - 3328; sig = true; }
        const int col0 = c0 + wc * 32 + 8 * fq;
#pragma unroll
        for (int ai = 0; ai < 2; ++ai)
#pragma unroll
            for (int m = 0; m < 4; ++m) { bf16_t* rowp = base + (size_t)(row0 + ai * HALF + m * 16) * ldc + col0;
#pragma unroll
                for (int bj = 0; bj < 2; ++bj) { f32x4 v0 = acc[ai][bj][m][0], v1 = acc[ai][bj][m][1];
                    if (sig) {
#pragma unroll
                        for (int e = 0; e < 4; ++e) { v0[e] = sigmoid_f(v0[e]); v1[e] = sigmoid_f(v1[e]); } }
                    else { v0 = v0 * sc; v1 = v1 * sc; }
                    u32x4 w; w.x = cvt_pk_bf16(v0[0], v0[1]); w.y = cvt_pk_bf16(v0[2], v0[3]); w.z = cvt_pk_bf16(v1[0], v1[1]); w.w = cvt_pk_bf16(v1[2], v1[3]);
                    *(u32x4*)(rowp + bj * HALF) = w; } }
    }
};
struct EpiLowrank {
    static constexpr bool PERM = false, AFTER_DRAIN = false;
    float* DEC; bf16_t* AA; size_t GGOFF; const float* w0; const float* a0;
    __device__ __forceinline__ void operator()(const f32x4 (&acc)[2][2][4][2], const Unit& u, int wr, int wc, int fr, int fq) const {
        const int row0 = u.pm * BM + wr * 64 + fr; const int colt = u.pn * BM; const int kind = colt >> 9;
        const int cb = (colt & 511) + wc * 32 + 4 * fq;
        bf16_t* dst16 = AA + (kind == 2 ? GGOFF : (size_t)0);
#pragma unroll
        for (int bj = 0; bj < 2; ++bj)
#pragma unroll
            for (int n = 0; n < 2; ++n) { const int c = cb + bj * HALF + n * 16;
                f32x4 bv = (f32x4){0.f, 0.f, 0.f, 0.f};
                if (kind == 0) bv = *(const f32x4*)(w0 + c); else if (kind == 1) bv = *(const f32x4*)(a0 + c);
#pragma unroll
                for (int ai = 0; ai < 2; ++ai)
#pragma unroll
                    for (int m = 0; m < 4; ++m) { const size_t off = (size_t)(row0 + ai * HALF + m * 16) * 512 + c; f32x4 v = acc[ai][bj][m][n] + bv;
                        if (kind == 0) {
#pragma unroll
                            for (int e = 0; e < 4; ++e) { const float y = -v[e];
                                const float sp = fmaxf(y, 0.f) + 0.6931471805599453f * __builtin_amdgcn_logf(1.0f + __builtin_amdgcn_exp2f(-fabsf(y) * LOG2E));
                                const float lam = __builtin_amdgcn_exp2f((-sp - 0.5f) * LOG2E); v[e] = __builtin_amdgcn_exp2f(-lam * LOG2E); }
                            *(f32x4*)(DEC + off) = v;
                        } else {
                            if (kind == 1) {
#pragma unroll
                                for (int e = 0; e < 4; ++e) v[e] = sigmoid_f(v[e]); }
                            u32x2 w; w.x = cvt_pk_bf16(v[0], v[1]); w.y = cvt_pk_bf16(v[2], v[3]);
                            *(u32x2*)(dst16 + off) = w; } } }
    }
};
template <int WHICH> struct EpiUp {
    static constexpr bool PERM = true, AFTER_DRAIN = false;
    const bf16_t* GT; bf16_t* T;
    __device__ __forceinline__ void operator()(const f32x4 (&acc)[2][2][4][2], const Unit& u, int wr, int wc, int fr, int fq) const {
        const int row0 = u.pm * BM + wr * 64 + fr; const int col0 = u.pn * BM + wc * 32 + 8 * fq;
#pragma unroll
        for (int ai = 0; ai < 2; ++ai)
#pragma unroll
            for (int m = 0; m < 4; ++m) { const size_t row = (size_t)(row0 + ai * HALF + m * 16);
#pragma unroll
                for (int bj = 0; bj < 2; ++bj) { const int c = col0 + bj * HALF;
                    const u32x4 g = *(const u32x4*)(GT + row * 2048 + WHICH * 1024 + c);
                    const f32x4 v0 = acc[ai][bj][m][0], v1 = acc[ai][bj][m][1];
                    float r[8] = { bf_lo(g.x) * v0[0], bf_hi(g.x) * v0[1], bf_lo(g.y) * v0[2], bf_hi(g.y) * v0[3], bf_lo(g.z) * v1[0], bf_hi(g.z) * v1[1], bf_lo(g.w) * v1[2], bf_hi(g.w) * v1[3] };
                    if (WHICH == 1) { const u32x4 t = *(const u32x4*)(T + row * 1024 + c);
                        r[0] += bf_lo(t.x); r[1] += bf_hi(t.x); r[2] += bf_lo(t.y); r[3] += bf_hi(t.y); r[4] += bf_lo(t.z); r[5] += bf_hi(t.z); r[6] += bf_lo(t.w); r[7] += bf_hi(t.w); }
                    u32x4 w; w.x = cvt_pk_bf16(r[0], r[1]); w.y = cvt_pk_bf16(r[2], r[3]); w.z = cvt_pk_bf16(r[4], r[5]); w.w = cvt_pk_bf16(r[6], r[7]);
                    *(u32x4*)(T + row * 1024 + c) = w; } }
    }
};
struct EpiOutZ {
    static constexpr bool PERM = false, AFTER_DRAIN = false;
    const float* x; const float* stats; const float* g_in; const float* b_in; float* Z;
    __device__ __forceinline__ void operator()(const f32x4 (&acc)[2][2][4][2], const Unit& u, int wr, int wc, int fr, int fq) const {
        const int row0 = u.pm * BM + wr * 64 + fr; const int cb = u.pn * BM + wc * 32 + 4 * fq;
#pragma unroll
        for (int bj = 0; bj < 2; ++bj)
#pragma unroll
            for (int n = 0; n < 2; ++n) { const int c = cb + bj * HALF + n * 16; const f32x4 gi = *(const f32x4*)(g_in + c), bi = *(const f32x4*)(b_in + c);
#pragma unroll
                for (int ai = 0; ai < 2; ++ai)
#pragma unroll
                    for (int m = 0; m < 4; ++m) { const size_t row = (size_t)(row0 + ai * HALF + m * 16); const float mean = stats[row * 2], rstd = stats[row * 2 + 1];
                        const f32x4 xv = *(const f32x4*)(x + row * 1024 + c); const f32x4 h = (xv - mean) * rstd * gi + bi;
                        *(f32x4*)(Z + row * 1024 + c) = h * ALPHA + acc[ai][bj][m][n]; } }
    }
};
struct EpiSwiglu {
    static constexpr bool PERM = true, AFTER_DRAIN = false;
    bf16_t* ACT;
    __device__ __forceinline__ void operator()(const f32x4 (&acc)[2][2][4][2], const Unit& u, int wr, int wc, int fr, int fq) const {
        const int row0 = u.pm * BM + wr * 64 + fr; const int col0 = u.pn * HALF + wc * 32 + 8 * fq;
#pragma unroll
        for (int ai = 0; ai < 2; ++ai)
#pragma unroll
            for (int m = 0; m < 4; ++m) { const size_t row = (size_t)(row0 + ai * HALF + m * 16);
                float r[8];
#pragma unroll
                for (int n = 0; n < 2; ++n)
#pragma unroll
                    for (int e = 0; e < 4; ++e) { const float g = acc[ai][0][m][n][e], up = acc[ai][1][m][n][e]; r[4 * n + e] = g * sigmoid_f(g) * up; }
                u32x4 w; w.x = cvt_pk_bf16(r[0], r[1]); w.y = cvt_pk_bf16(r[2], r[3]); w.z = cvt_pk_bf16(r[4], r[5]); w.w = cvt_pk_bf16(r[6], r[7]);
                *(u32x4*)(ACT + row * FFH + col0) = w; }
    }
};
struct EpiDownZ {
    static constexpr bool PERM = false, AFTER_DRAIN = false;
    float* Z;
    __device__ __forceinline__ void operator()(const f32x4 (&acc)[2][2][4][2], const Unit& u, int wr, int wc, int fr, int fq) const {
        const int row0 = u.pm * BM + wr * 64 + fr; const int cb = u.pn * BM + wc * 32 + 4 * fq;
#pragma unroll
        for (int ai = 0; ai < 2; ++ai)
#pragma unroll
            for (int m = 0; m < 4; ++m) { const size_t row = (size_t)(row0 + ai * HALF + m * 16);
#pragma unroll
                for (int bj = 0; bj < 2; ++bj)
#pragma unroll
                    for (int n = 0; n < 2; ++n) { float* p = Z + row * 1024 + cb + bj * HALF + n * 16; const f32x4 h = *(const f32x4*)p; *(f32x4*)p = h * ALPHA + acc[ai][bj][m][n]; } }
    }
};

template <class Epi, class Sched, bool ALIGN_EPI = false, bool SP2 = false>
__device__ __forceinline__ void gemm_phase(PG8_LAS unsigned char* lds, const Gemm g, const Sched& S, const Epi& E) {
    const int tid = threadIdx.x, wid = __builtin_amdgcn_readfirstlane(tid >> 6), lane = tid & 63, wr = wid >> 2, wc = wid & 3, fr = lane & 15, fq = lane >> 4;
    const int K = g.K, nt = K / BK;
    unsigned voffA[2], voffB[2];
#pragma unroll
    for (int i = 0; i < 2; ++i) { int R, C; stage_rc(tid * 16 + i * 8192, R, C); const int Rb = Epi::PERM ? ((R & ~31) + perm32(R & 31)) : R;
        voffA[i] = (unsigned)(R * K + C) * 2u; voffB[i] = (unsigned)(Rb * K + C) * 2u; }
    const size_t kstep = (size_t)(BK * 2);
    const size_t hstep = (size_t)HALF * K * 2;
    const size_t tstep = 2 * hstep;
    const unsigned ldsw = (unsigned)wid * 1024u;
    const int aoff = lds_byte(wr * 64 + fr, fq * 8), boff = lds_byte(wc * 32 + fr, fq * 8);
#define PG8_SA(b, h) (((b) * 2 + (h)) * HTB)
#define PG8_SB(b, h) ((4 + (b) * 2 + (h)) * HTB)
#define PG8_STAGE(bufoff, gbase, voff) do { _Pragma("unroll") for (int _i = 0; _i < 2; ++_i) \
        __builtin_amdgcn_global_load_lds((const unsigned*)((const char*)(gbase) + (voff)[_i]), (PG8_LAS unsigned*)(lds + (bufoff) + ldsw + _i * 8192), 16, 0, 0); } while (0)
#define PG8_LDA(dst, b, h) do { _Pragma("unroll") for (int m = 0; m < 4; ++m) _Pragma("unroll") for (int k = 0; k < 2; ++k) dst[m][k] = *(const PG8_LAS bf16x8*)(lds + PG8_SA(b, h) + aoff + m * 2048 + k * 1024); } while (0)
#define PG8_LDB(dst, b, h) do { _Pragma("unroll") for (int n = 0; n < 2; ++n) _Pragma("unroll") for (int k = 0; k < 2; ++k) dst[n][k] = *(const PG8_LAS bf16x8*)(lds + PG8_SB(b, h) + boff + n * 2048 + k * 1024); } while (0)
#define PG8_MMA(ai, bj, At, Bt) do { __builtin_amdgcn_s_setprio(1); _Pragma("unroll") for (int m = 0; m < 4; ++m) _Pragma("unroll") for (int n = 0; n < 2; ++n) _Pragma("unroll") for (int k = 0; k < 2; ++k) \
        acc[ai][bj][m][n] = __builtin_amdgcn_mfma_f32_16x16x32_bf16(Bt[n][k], At[m][k], acc[ai][bj][m][n], 0, 0, 0); __builtin_amdgcn_s_setprio(0); } while (0)
#define PG8_WAIT_V(n) asm volatile("s_waitcnt vmcnt(" #n ")" ::: "memory")
#define PG8_WAIT_L(n) asm volatile("s_waitcnt lgkmcnt(" #n ")" ::: "memory")
#define PG8_BAR __builtin_amdgcn_s_barrier()
#define PG8_SCHED __builtin_amdgcn_sched_barrier(0)
    Unit cur, nxt; int ui = 0;
    if (!S.next(0, cur)) return;
    f32x4 acc[2][2][4][2];
#pragma unroll
    for (int a = 0; a < 2; ++a)
#pragma unroll
        for (int b = 0; b < 2; ++b)
#pragma unroll
            for (int m = 0; m < 4; ++m)
#pragma unroll
                for (int n = 0; n < 2; ++n) acc[a][b][m][n] = (f32x4){0.f, 0.f, 0.f, 0.f};
    bf16x8 At[4][2], B0[2][2], B1[2][2];
    const char* cA = (const char*)g.A + (size_t)cur.pm * tstep; const char* cB = (const char*)g.Bt + (size_t)cur.pn * tstep;
    S.a_ready(cur);
    if constexpr (SP2) {
        PG8_STAGE(PG8_SB(0, 0), cB, voffB); PG8_STAGE(PG8_SB(0, 1), cB + hstep, voffB); PG8_STAGE(PG8_SA(0, 0), cA, voffA); PG8_STAGE(PG8_SA(0, 1), cA + hstep, voffA);
        if (wr == 1) PG8_BAR;
        PG8_WAIT_V(2); PG8_BAR;
        PG8_STAGE(PG8_SB(1, 0), cB + kstep, voffB); PG8_STAGE(PG8_SA(1, 0), cA + kstep, voffA); PG8_STAGE(PG8_SB(1, 1), cB + hstep + kstep, voffB);
        PG8_WAIT_V(6); PG8_BAR;
    } else {
        PG8_STAGE(PG8_SB(0, 0), cB, voffB); PG8_STAGE(PG8_SA(0, 0), cA, voffA); PG8_STAGE(PG8_SB(0, 1), cB + hstep, voffB); PG8_STAGE(PG8_SA(0, 1), cA + hstep, voffA);
        if (wr == 1) PG8_BAR;
        PG8_WAIT_V(4); PG8_BAR;
        PG8_STAGE(PG8_SB(1, 0), cB + kstep, voffB); PG8_STAGE(PG8_SA(1, 0), cA + kstep, voffA); PG8_STAGE(PG8_SB(1, 1), cB + hstep + kstep, voffB);
        PG8_WAIT_V(6); PG8_BAR;
    }
    for (;;) {
        const bool has_next = S.next(ui + 1, nxt);
        const char* nA = has_next ? (const char*)g.A + (size_t)nxt.pm * tstep : cA; const char* nB = has_next ? (const char*)g.Bt + (size_t)nxt.pn * tstep : cB;
        for (int t = 0; t < nt; t += 2) {
            const bool last = (t == nt - 2);
            const char* a1 = cA + (size_t)(t + 1) * kstep;
            const char* a2 = last ? nA : cA + (size_t)(t + 2) * kstep; const char* b2 = last ? nB : cB + (size_t)(t + 2) * kstep;
            const char* a3 = a2 + kstep; const char* b3 = b2 + kstep;
            if (last && has_next) S.a_ready(nxt);
            if constexpr (SP2) {
            PG8_LDB(B0, 0, 0); PG8_LDB(B1, 0, 1); PG8_SCHED; PG8_LDA(At, 0, 0); PG8_STAGE(PG8_SA(1, 1), a1 + hstep, voffA);
            PG8_WAIT_V(8); PG8_WAIT_L(0); PG8_BAR; PG8_MMA(0, 0, At, B0); PG8_MMA(0, 1, At, B1); PG8_BAR; PG8_SCHED;
            PG8_LDA(At, 0, 1); PG8_STAGE(PG8_SB(0, 0), b2, voffB); PG8_STAGE(PG8_SB(0, 1), b2 + hstep, voffB); PG8_STAGE(PG8_SA(0, 0), a2, voffA);
            PG8_WAIT_V(8); PG8_WAIT_L(0); PG8_BAR; PG8_MMA(1, 0, At, B0); PG8_MMA(1, 1, At, B1); PG8_BAR; PG8_SCHED;
            PG8_LDB(B0, 1, 0); PG8_LDB(B1, 1, 1); PG8_SCHED; PG8_LDA(At, 1, 0); PG8_STAGE(PG8_SA(0, 1), a2 + hstep, voffA);
            PG8_WAIT_V(8); PG8_WAIT_L(0); PG8_BAR; PG8_MMA(0, 0, At, B0); PG8_MMA(0, 1, At, B1); PG8_BAR; PG8_SCHED;
            PG8_LDA(At, 1, 1); PG8_STAGE(PG8_SB(1, 0), b3, voffB); PG8_STAGE(PG8_SB(1, 1), b3 + hstep, voffB); PG8_STAGE(PG8_SA(1, 0), a3, voffA);
            PG8_WAIT_V(8); PG8_WAIT_L(0); PG8_BAR; PG8_MMA(1, 0, At, B0); PG8_MMA(1, 1, At, B1); PG8_BAR; PG8_SCHED;
            } else {
            PG8_LDB(B0, 0, 0); PG8_SCHED; PG8_LDA(At, 0, 0); PG8_STAGE(PG8_SA(1, 1), a1 + hstep, voffA);
            PG8_WAIT_L(8); PG8_BAR; PG8_WAIT_L(0); PG8_MMA(0, 0, At, B0); PG8_BAR; PG8_SCHED;
            PG8_LDB(B1, 0, 1); PG8_STAGE(PG8_SB(0, 0), b2, voffB);
            PG8_BAR; PG8_WAIT_L(0); PG8_MMA(0, 1, At, B1); PG8_BAR;
            PG8_LDA(At, 0, 1); PG8_STAGE(PG8_SA(0, 0), a2, voffA);
            PG8_BAR; PG8_WAIT_L(0); PG8_MMA(1, 0, At, B0); PG8_BAR; PG8_SCHED;
            PG8_STAGE(PG8_SB(0, 1), b2 + hstep, voffB);
            PG8_WAIT_V(6); PG8_BAR; PG8_MMA(1, 1, At, B1); PG8_BAR;
            PG8_LDB(B0, 1, 0); PG8_SCHED; PG8_LDA(At, 1, 0); PG8_STAGE(PG8_SA(0, 1), a2 + hstep, voffA);
            PG8_WAIT_L(8); PG8_BAR; PG8_WAIT_L(0); PG8_MMA(0, 0, At, B0); PG8_BAR; PG8_SCHED;
            PG8_LDB(B1, 1, 1); PG8_STAGE(PG8_SB(1, 0), b3, voffB);
            PG8_BAR; PG8_WAIT_L(0); PG8_MMA(0, 1, At, B1); PG8_BAR;
            PG8_LDA(At, 1, 1); PG8_STAGE(PG8_SA(1, 0), a3, voffA);
            PG8_BAR; PG8_WAIT_L(0); PG8_MMA(1, 0, At, B0); PG8_BAR; PG8_SCHED;
            PG8_STAGE(PG8_SB(1, 1), b3 + hstep, voffB);
            PG8_WAIT_V(6); PG8_BAR; PG8_MMA(1, 1, At, B1); PG8_BAR;
            }
        }
        if constexpr (ALIGN_EPI) { if (wr == 0) PG8_BAR; }
        if constexpr (!Epi::AFTER_DRAIN) { E(acc, cur, wr, wc, fr, fq); S.done(cur); }
        if (!has_next) break;
#pragma unroll
        for (int a = 0; a < 2; ++a)
#pragma unroll
            for (int b = 0; b < 2; ++b)
#pragma unroll
                for (int m = 0; m < 4; ++m)
#pragma unroll
                    for (int n = 0; n < 2; ++n) acc[a][b][m][n] = (f32x4){0.f, 0.f, 0.f, 0.f};
        cur = nxt; cA = nA; cB = nB; ++ui;
        if constexpr (ALIGN_EPI) { if (wr == 1) PG8_BAR; }
    }
    PG8_WAIT_V(0);
    if constexpr (!ALIGN_EPI) { if (wr == 0) PG8_BAR; }
    PG8_BAR;
    if constexpr (Epi::AFTER_DRAIN) { E.fused(acc, cur, wr, wc, fr, fq, lds, wid, lane); S.done(cur); }
#undef PG8_SA
#undef PG8_SB
#undef PG8_STAGE
#undef PG8_LDA
#undef PG8_LDB
#undef PG8_MMA
#undef PG8_WAIT_V
#undef PG8_WAIT_L
#undef PG8_BAR
#undef PG8_SCHED
}
}
constexpr int NWAVES = 8;
constexpr size_t MiB = 1u << 20;
constexpr size_t WS_CTL = 0, CTL_ZERO_BYTES = 1 * MiB;
constexpr size_t WS_STATS = 1 * MiB;
constexpr size_t WS_INVN = 1 * MiB + 512 * 1024;
constexpr size_t WS_WIN = 3 * MiB;
constexpr size_t WS_WUPA = WS_WIN + 10 * MiB + 512 * 1024;
constexpr size_t WS_WUPB = WS_WUPA + 1 * MiB;
constexpr size_t WS_WOUT = WS_WUPB + 1 * MiB;
constexpr size_t WS_WGU = WS_WOUT + 2 * MiB;
constexpr size_t WS_WDN = WS_WGU + 11 * MiB;
constexpr size_t WS_B2 = WS_WDN + 5 * MiB + 512 * 1024;
constexpr size_t WS_Q = 35 * MiB;
constexpr size_t WS_HN = 131 * MiB;
constexpr size_t WS_RR = 131 * MiB, WS_KK = 163 * MiB, WS_VV = 195 * MiB;
constexpr size_t WS_RW = 227 * MiB;
constexpr size_t WS_DEC = 227 * MiB, WS_AA = 291 * MiB;
constexpr size_t WS_A2 = 339 * MiB;
constexpr size_t WS_YB = 323 * MiB;
constexpr size_t WS_GG = 355 * MiB;
constexpr size_t WS_O = 387 * MiB;
constexpr size_t WS_T = 131 * MiB;
constexpr size_t WS_H1B = 195 * MiB;
constexpr size_t WS_ACT = 259 * MiB;
constexpr size_t WS_END = 451 * MiB;
static_assert(WS_B2 + 1536 * 256 * 2 <= WS_Q, "weights fit");
constexpr int CW_TMO = 0, CW_CODE = 1, CW_BAR = 4096;
constexpr int RING_OFF = 0, RING_BYTES = 131072;
constexpr int LDSCTL_OFF = RING_BYTES, MISC_OFF = LDSCTL_OFF + 320;
constexpr int LDS_BYTES = 147456;

#define GAS __attribute__((address_space(1)))
#define LAS __attribute__((address_space(3)))
typedef unsigned short bf16;
typedef unsigned v4u __attribute__((ext_vector_type(4)));
typedef float f32x4 __attribute__((ext_vector_type(4)));
typedef short bf16x8 __attribute__((ext_vector_type(8)));
typedef GAS unsigned gu32;
typedef GAS unsigned long long gu64;
#define RLX_AGENT __ATOMIC_RELAXED, __HIP_MEMORY_SCOPE_AGENT
#define LDS_WAIT() asm volatile("s_waitcnt lgkmcnt(0)" ::: "memory")
#define VM_WAIT() asm volatile("s_waitcnt vmcnt(0)" ::: "memory")
__device__ __forceinline__ unsigned long long rt() { return __builtin_amdgcn_s_memrealtime(); }
__device__ __forceinline__ unsigned f2bf(float f) { unsigned u = __builtin_bit_cast(unsigned, f); return (u + 0x7fffu + ((u >> 16) & 1u)) >> 16; }
__device__ __forceinline__ unsigned pk2(float lo, float hi) { return f2bf(lo) | (f2bf(hi) << 16); }

#define XB_TMO      128
#define XB_XCNT(j)  (256  + 64 * (j))
#define XB_XSUB(j)  (1280 + 64 * (j))
#define XB_XGEN(j)  (2304 + 64 * (j))
#define XB_TOP      3328
#define XB_TOPGEN   3392
#define XCD_BAR_WORDS 3456
#define XB_SPIN_CAP (1u << 18)

__device__ __forceinline__ unsigned xb_ld(unsigned* p)              { return __hip_atomic_load(p, __ATOMIC_RELAXED, __HIP_MEMORY_SCOPE_AGENT); }
__device__ __forceinline__ unsigned xb_add(unsigned* p, unsigned v) { return __hip_atomic_fetch_add(p, v, __ATOMIC_RELAXED, __HIP_MEMORY_SCOPE_AGENT); }
__device__ __forceinline__ unsigned xb_xcc_id() { return (unsigned)__builtin_amdgcn_s_getreg((3 << 11) | 20) & 0xFu; }
#define XB_SPIN(cond, bar) do { unsigned _sp = 0; while (cond) { __builtin_amdgcn_s_sleep(1); \
    if ((++_sp & 255u) == 0u) { if (xb_ld(&(bar)[XB_TMO])) break; if (_sp > XB_SPIN_CAP) { atomicAdd(&(bar)[XB_TMO], 1u); break; } } } } while (0)

struct XcdBarrier {
    unsigned* bar; unsigned x;
    volatile LAS unsigned* st;
};

__device__ __forceinline__ XcdBarrier xcd_barrier_post(unsigned* bar, volatile LAS unsigned* st) {
    XcdBarrier b; b.bar = bar; b.x = xb_xcc_id(); b.st = st;
    if (threadIdx.x == 0) (void)xb_add(&bar[XB_XCNT(b.x)], 1u);
    return b;
}
__device__ __forceinline__ void xcd_barrier_complete(unsigned* bar, unsigned x, unsigned& nloc, unsigned& nx) {
    const unsigned G = gridDim.x * gridDim.y * gridDim.z;
    unsigned sum, cnt, mine, sp = 0u;
    for (;;) {
        sum = 0u; cnt = 0u; mine = 0u;
#pragma unroll
        for (unsigned j = 0; j < 16; ++j) { const unsigned c = xb_ld(&bar[XB_XCNT(j)]); sum += c; cnt += (c > 0u) ? 1u : 0u; mine = (j == x) ? c : mine; }
        if (sum == G) break;
        __builtin_amdgcn_s_sleep(1);
        if ((++sp & 255u) == 0u) { if (xb_ld(&bar[XB_TMO])) break; if (sp > XB_SPIN_CAP) { atomicAdd(&bar[XB_TMO], 1u); break; } }
    }
    nloc = mine > 0u ? mine : 1u; nx = cnt > 0u ? cnt : 1u;
}

__device__ __forceinline__ void xcd_barrier(const XcdBarrier& b) {
    asm volatile("s_waitcnt vmcnt(0)" ::: "memory");
    __syncthreads();
    if (threadIdx.x == 0) {
        unsigned* bar = b.bar;
        __builtin_amdgcn_s_waitcnt(0);
        unsigned nloc = b.st[0], nx = b.st[1];
        if (nloc == 0u) { xcd_barrier_complete(bar, b.x, nloc, nx); b.st[0] = nloc; b.st[1] = nx; }
        const unsigned old = xb_add(&bar[XB_XSUB(b.x)], 1u);
        const unsigned gen = old / nloc;
        if (old + 1u == (gen + 1u) * nloc) {
            __builtin_amdgcn_fence(__ATOMIC_RELEASE, "agent");
            asm volatile("s_waitcnt vmcnt(0)" ::: "memory");
            const unsigned og = xb_add(&bar[XB_TOP], 1u);
            const unsigned tg = og / nx;
            if (og + 1u == (tg + 1u) * nx) xb_add(&bar[XB_TOPGEN], 1u);
            else XB_SPIN(xb_ld(&bar[XB_TOPGEN]) == tg, bar);
            __builtin_amdgcn_fence(__ATOMIC_ACQUIRE, "agent");
            xb_add(&bar[XB_XGEN(b.x)], 1u);
            asm volatile("s_waitcnt vmcnt(0)" ::: "memory");
        } else {
            XB_SPIN(xb_ld(&bar[XB_XGEN(b.x)]) == gen, bar);
            __builtin_amdgcn_fence(__ATOMIC_ACQUIRE, "agent");
            asm volatile("s_waitcnt vmcnt(0)" ::: "memory");
        }
    }
    __syncthreads();
}
struct Args { const float* in[31]; float* out; unsigned char* ws; int ph_lo, ph_hi; };
struct Frame {
    LAS unsigned char* lds; volatile LAS unsigned* MISC; gu32* ctl;
    int tid, lane, wave, vcu, G;
};
__device__ __forceinline__ float wave_sum(float v) {
#pragma unroll
    for (int o = 1; o < 64; o <<= 1) v += __shfl_xor(v, o);
    return v;
}
using pg8::bf_lo; using pg8::bf_hi;

__device__ __forceinline__ void p0_transpose_item(const float* W, int ldw, bf16* WT, int Kd, int drow, int k0, int n0, LAS float* scr, int lane) {
#pragma unroll 8
    for (int i = 0; i < 32; ++i) { const int kk = 2 * i + (lane >> 5); scr[kk * 33 + (lane & 31)] = W[(size_t)(k0 + kk) * ldw + n0 + (lane & 31)]; }
    LDS_WAIT(); asm volatile("" ::: "memory");
    const int c = lane & 7;
#pragma unroll
    for (int j = 0; j < 4; ++j) { const int n = (lane >> 3) + 8 * j; const LAS float* s = scr + (8 * c) * 33 + n;
        v4u o; o.x = pk2(s[0 * 33], s[1 * 33]); o.y = pk2(s[2 * 33], s[3 * 33]); o.z = pk2(s[4 * 33], s[5 * 33]); o.w = pk2(s[6 * 33], s[7 * 33]);
        *(GAS v4u*)(WT + (size_t)(drow + n) * Kd + k0 + 8 * c) = o; }
    LDS_WAIT(); asm volatile("" ::: "memory");
}
__device__ __forceinline__ void ln_row(const float* xrow, const float* g, const float* b, float* of32, bf16* obf, float* stat, int lane) {
    const f32x4* xr = (const f32x4*)xrow + lane;
    f32x4 v[4]; float s = 0.f;
#pragma unroll
    for (int j = 0; j < 4; ++j) { v[j] = xr[64 * j]; s += (v[j].x + v[j].y) + (v[j].z + v[j].w); }
    const float mean = wave_sum(s) * (1.f / DM); float s2 = 0.f;
#pragma unroll
    for (int j = 0; j < 4; ++j) { v[j] = v[j] - mean; s2 += (v[j].x * v[j].x + v[j].y * v[j].y) + (v[j].z * v[j].z + v[j].w * v[j].w); }
    const float rstd = 1.f / sqrtf(wave_sum(s2) * (1.f / DM) + LN_EPS);
    if (stat && lane == 0) { stat[0] = mean; stat[1] = rstd; }
#pragma unroll
    for (int j = 0; j < 4; ++j) { const f32x4 gg = ((const f32x4*)g)[lane + 64 * j], bb = ((const f32x4*)b)[lane + 64 * j]; const f32x4 y = v[j] * rstd * gg + bb;
        if (of32) ((f32x4*)of32)[lane + 64 * j] = y;
        if (obf) ((unsigned long long*)obf)[lane + 64 * j] = (unsigned long long)pk2(y.x, y.y) | ((unsigned long long)pk2(y.z, y.w) << 32); }
}
__device__ __forceinline__ void p0_prologue(Frame& F, const Args& a) {
    unsigned char* ws = a.ws;
    LAS float* scr = (LAS float*)(F.lds + RING_OFF + F.wave * 16384);
    const int gw = F.vcu * NWAVES + F.wave, NGW = F.G * NWAVES;
    constexpr int I_IN = 16 * 168, I_UP = 8 * 32, I_OUT = 16 * 32, I_G = 16 * 88, I_DN = 44 * 32;
    constexpr int NITEMS = I_IN + 2 * I_UP + I_OUT + 2 * I_G + I_DN;
    for (int it = gw; it < NITEMS; it += NGW) {
        int r = it;
        if (r < I_IN) { const int kb = r / 168, nb = r % 168; p0_transpose_item(a.in[4], NPROJ, (bf16*)(ws + WS_WIN), 1024, 32 * nb, 64 * kb, 32 * nb, scr, F.lane); continue; } r -= I_IN;
        if (r < I_UP) { const int kb = r / 32, nb = r % 32; p0_transpose_item(a.in[21], 1024, (bf16*)(ws + WS_WUPA), 512, 32 * nb, 64 * kb, 32 * nb, scr, F.lane); continue; } r -= I_UP;
        if (r < I_UP) { const int kb = r / 32, nb = r % 32; p0_transpose_item(a.in[22], 1024, (bf16*)(ws + WS_WUPB), 512, 32 * nb, 64 * kb, 32 * nb, scr, F.lane); continue; } r -= I_UP;
        if (r < I_OUT) { const int kb = r / 32, nb = r % 32; p0_transpose_item(a.in[23], 1024, (bf16*)(ws + WS_WOUT), 1024, 32 * nb, 64 * kb, 32 * nb, scr, F.lane); continue; } r -= I_OUT;
        if (r < I_G) { const int kb = r / 88, nb = r % 88, n0 = 32 * nb; p0_transpose_item(a.in[26], FFH, (bf16*)(ws + WS_WGU), 1024, 256 * (n0 >> 7) + (n0 & 127), 64 * kb, n0, scr, F.lane); continue; } r -= I_G;
        if (r < I_G) { const int kb = r / 88, nb = r % 88, n0 = 32 * nb; p0_transpose_item(a.in[27], FFH, (bf16*)(ws + WS_WGU), 1024, 256 * (n0 >> 7) + 128 + (n0 & 127), 64 * kb, n0, scr, F.lane); continue; } r -= I_G;
        { const int kb = r / 32, nb = r % 32; p0_transpose_item(a.in[28], 1024, (bf16*)(ws + WS_WDN), FFH, 32 * nb, 64 * kb, 32 * nb, scr, F.lane); }
    }
    { bf16* B2 = (bf16*)(ws + WS_B2); const float* w2 = a.in[12]; const float* a2 = a.in[14]; const float* g2 = a.in[15];
      for (int e = (F.vcu * 512 + F.tid); e < 1536 * 256; e += F.G * 512) { const int n = e >> 8, k = e & 255; float v = 0.f;
          if (n < 512) { if (k < 64) v = w2[k * 512 + n]; }
          else if (n < 1024) { if (k >= 64 && k < 128) v = a2[(k - 64) * 512 + (n - 512)]; }
          else { if (k >= 128) v = g2[(k - 128) * 512 + (n - 1024)]; }
          B2[e] = (bf16)(pk2(v, 0.f) & 0xffffu); } }
    for (int m = gw; m < MTOK; m += NGW) ln_row(a.in[0] + (size_t)m * DM, a.in[1], a.in[2], nullptr, (bf16*)(ws + WS_HN) + (size_t)m * DM, (float*)(ws + WS_STATS) + 2 * m, F.lane);
}
__device__ __forceinline__ void p2a_shift(Frame& F, const Args& a) {
    unsigned char* ws = a.ws;
    const bf16* RW = (const bf16*)(ws + WS_RW); const float* mu = a.in[10]; const float* k_k = a.in[16];
    bf16* RR = (bf16*)(ws + WS_RR); bf16* KK = (bf16*)(ws + WS_KK); bf16* VV = (bf16*)(ws + WS_VV); bf16* A2 = (bf16*)(ws + WS_A2); float* INV = (float*)(ws + WS_INVN);
    const int gw = F.vcu * NWAVES + F.wave, NGW = F.G * NWAVES, lane = F.lane;
    for (int m = gw; m < MTOK; m += NGW) {
        const bool first = (m & (SEQ - 1)) == 0;
#pragma unroll
        for (int it = 0; it < 4; ++it) {
            const int c0 = lane * 8 + it * 512;
            if (it < 3 || lane < 32) {
                const v4u cur = *(const v4u*)(RW + (size_t)m * 1792 + c0);
                v4u prv = (v4u){0u, 0u, 0u, 0u}; if (!first) prv = *(const v4u*)(RW + (size_t)(m - 1) * 1792 + c0);
                const f32x4 m0 = *(const f32x4*)(mu + c0), m1 = *(const f32x4*)(mu + c0 + 4);
                float xs[8];
                { const unsigned cw[4] = {cur.x, cur.y, cur.z, cur.w}, pw[4] = {prv.x, prv.y, prv.z, prv.w}; const float mm[8] = {m0.x, m0.y, m0.z, m0.w, m1.x, m1.y, m1.z, m1.w};
#pragma unroll
                  for (int e = 0; e < 4; ++e) { const float c_lo = bf_lo(cw[e]), c_hi = bf_hi(cw[e]), p_lo = bf_lo(pw[e]), p_hi = bf_hi(pw[e]);
                      xs[2 * e] = c_lo + (p_lo - c_lo) * mm[2 * e]; xs[2 * e + 1] = c_hi + (p_hi - c_hi) * mm[2 * e + 1]; } }
                if (it == 3) {
                    const int cl = lane * 8;
#pragma unroll
                    for (int e = 0; e < 8; ++e) { if (cl < 64) xs[e] = tanhf(xs[e]); else if (cl >= 128) xs[e] = 1.0f / (1.0f + expf(-xs[e])); }
                    v4u o; o.x = pk2(xs[0], xs[1]); o.y = pk2(xs[2], xs[3]); o.z = pk2(xs[4], xs[5]); o.w = pk2(xs[6], xs[7]);
                    *(v4u*)(A2 + (size_t)m * 256 + cl) = o;
                } else {
                    v4u o; o.x = pk2(xs[0], xs[1]); o.y = pk2(xs[2], xs[3]); o.z = pk2(xs[4], xs[5]); o.w = pk2(xs[6], xs[7]);
                    const int cc = lane * 8;
                    bf16* dst = (it == 0) ? RR : (it == 1) ? KK : VV;
                    *(v4u*)(dst + (size_t)m * 512 + cc) = o;
                    if (it == 1) {
                        const f32x4 k0 = *(const f32x4*)(k_k + cc), k1 = *(const f32x4*)(k_k + cc + 4);
                        const float kq[8] = {k0.x, k0.y, k0.z, k0.w, k1.x, k1.y, k1.z, k1.w}; const unsigned ow[4] = {o.x, o.y, o.z, o.w};
                        float ss = 0.f;
#pragma unroll
                        for (int e = 0; e < 4; ++e) { const float a0 = bf_lo(ow[e]) * kq[2 * e], a1 = bf_hi(ow[e]) * kq[2 * e + 1]; ss += a0 * a0 + a1 * a1; }
                        ss += __shfl_xor(ss, 1); ss += __shfl_xor(ss, 2); ss += __shfl_xor(ss, 4);
                        if ((lane & 7) == 0) INV[(size_t)m * 8 + (lane >> 3)] = 1.0f / sqrtf(fmaxf(ss, 1e-24f));
                    }
                }
            }
        }
    }
}
__device__ __forceinline__ int t5_bucket(int d) {
    if (d < 16) return d;
    int b = 16;
    b += (d >= 19); b += (d >= 21); b += (d >= 24); b += (d >= 27); b += (d >= 31); b += (d >= 35); b += (d >= 40); b += (d >= 46);
    b += (d >= 52); b += (d >= 59); b += (d >= 67); b += (d >= 77); b += (d >= 87); b += (d >= 99); b += (d >= 113);
    return b;
}
__device__ __forceinline__ float diff_lambda(const Args& a) {
    float s1 = 0.f, s2 = 0.f;
    for (int i = 0; i < 64; ++i) { s1 += a.in[5][i] * a.in[6][i]; s2 += a.in[7][i] * a.in[8][i]; }
    return expf(s1) - expf(s2) + 0.2f;
}
__device__ __forceinline__ void attn_naive(Frame& F, const Args& a) {
    unsigned char* ws = a.ws;
    const bf16* Q = (const bf16*)(ws + WS_Q); const bf16* K = Q + (size_t)MTOK * 512; const bf16* V = K + (size_t)MTOK * 512; bf16* O = (bf16*)(ws + WS_O);
    LAS float* btab = (LAS float*)(F.lds + RING_OFF);
    for (int e = F.tid; e < 512; e += 512) { const int h = e >> 7, d = e & 127; btab[e] = (a.in[3][t5_bucket(d) * 4 + h] - a.in[3][31 * 4 + h]) * LOG2E; }
    __syncthreads();
    const int blk = F.vcu;
    for (int i = 0; i < 4; ++i) {
        const int qc = i, b = blk >> 4, hcv = blk & 15, hc = hcv >> 1, vh = hcv & 1, h = hc >> 1;
        const int qpos = qc * 512 + F.tid; const size_t row = (size_t)b * SEQ + qpos;
        float q[64], o[64];
#pragma unroll
        for (int d8 = 0; d8 < 8; ++d8) { const v4u w = *(const v4u*)(Q + row * 512 + hc * 64 + d8 * 8);
            q[d8 * 8 + 0] = bf_lo(w.x); q[d8 * 8 + 1] = bf_hi(w.x); q[d8 * 8 + 2] = bf_lo(w.y); q[d8 * 8 + 3] = bf_hi(w.y);
            q[d8 * 8 + 4] = bf_lo(w.z); q[d8 * 8 + 5] = bf_hi(w.z); q[d8 * 8 + 6] = bf_lo(w.w); q[d8 * 8 + 7] = bf_hi(w.w); }
#pragma unroll
        for (int d = 0; d < 64; ++d) o[d] = 0.f;
        float mx = -1e30f, l = 0.f;
        const bf16* Kp = K + (size_t)b * SEQ * 512 + hc * 64; const bf16* Vp = V + (size_t)b * SEQ * 512 + h * 128 + vh * 64;
        const int jend = qc * 512 + (F.tid | 63);
        for (int j = 0; j <= jend; ++j) {
            float s = 0.f;
#pragma unroll
            for (int d8 = 0; d8 < 8; ++d8) { const v4u w = *(const v4u*)(Kp + (size_t)j * 512 + d8 * 8);
                s += q[d8 * 8 + 0] * bf_lo(w.x) + q[d8 * 8 + 1] * bf_hi(w.x) + q[d8 * 8 + 2] * bf_lo(w.y) + q[d8 * 8 + 3] * bf_hi(w.y)
                   + q[d8 * 8 + 4] * bf_lo(w.z) + q[d8 * 8 + 5] * bf_hi(w.z) + q[d8 * 8 + 6] * bf_lo(w.w) + q[d8 * 8 + 7] * bf_hi(w.w); }
            const int dist = qpos - j;
            if (dist >= 0) {
                s += btab[h * 128 + (dist < 127 ? dist : 127)];
                const float mn = fmaxf(mx, s), al = __builtin_amdgcn_exp2f(mx - mn), p = __builtin_amdgcn_exp2f(s - mn);
                l = l * al + p; mx = mn;
#pragma unroll
                for (int d8 = 0; d8 < 8; ++d8) { const v4u w = *(const v4u*)(Vp + (size_t)j * 512 + d8 * 8);
                    o[d8 * 8 + 0] = o[d8 * 8 + 0] * al + p * bf_lo(w.x); o[d8 * 8 + 1] = o[d8 * 8 + 1] * al + p * bf_hi(w.x);
                    o[d8 * 8 + 2] = o[d8 * 8 + 2] * al + p * bf_lo(w.y); o[d8 * 8 + 3] = o[d8 * 8 + 3] * al + p * bf_hi(w.y);
                    o[d8 * 8 + 4] = o[d8 * 8 + 4] * al + p * bf_lo(w.z); o[d8 * 8 + 5] = o[d8 * 8 + 5] * al + p * bf_hi(w.z);
                    o[d8 * 8 + 6] = o[d8 * 8 + 6] * al + p * bf_lo(w.w); o[d8 * 8 + 7] = o[d8 * 8 + 7] * al + p * bf_hi(w.w); }
            }
        }
        const float rl = 1.0f / l;
#pragma unroll
        for (int d8 = 0; d8 < 8; ++d8) { v4u w; w.x = pk2(o[d8 * 8 + 0] * rl, o[d8 * 8 + 1] * rl); w.y = pk2(o[d8 * 8 + 2] * rl, o[d8 * 8 + 3] * rl);
            w.z = pk2(o[d8 * 8 + 4] * rl, o[d8 * 8 + 5] * rl); w.w = pk2(o[d8 * 8 + 6] * rl, o[d8 * 8 + 7] * rl);
            *(v4u*)(O + row * 1024 + hc * 128 + vh * 64 + d8 * 8) = w; }
    }
    __syncthreads();
}
constexpr int SC_TC = 32;
__device__ __forceinline__ void scan_phase(Frame& F, const Args& a) {
    unsigned char* ws = a.ws;
    const bf16* RR = (const bf16*)(ws + WS_RR); const bf16* KK = (const bf16*)(ws + WS_KK); const bf16* VV = (const bf16*)(ws + WS_VV);
    const float* DEC = (const float*)(ws + WS_DEC); const bf16* AA = (const bf16*)(ws + WS_AA); const bf16* GG = (const bf16*)(ws + WS_GG); const float* INV = (const float*)(ws + WS_INVN);
    bf16* YB = (bf16*)(ws + WS_YB);
    const float* k_k = a.in[16]; const float* k_a = a.in[17]; const float* r_k = a.in[18]; const float* lnx_g = a.in[19]; const float* lnx_b = a.in[20];
    LAS float* L = (LAS float*)(F.lds + RING_OFF);
    LAS float* Ldec = L, *Lkk = L + SC_TC * 64, *Lbet = L + 2 * SC_TC * 64, *Lkp = L + 3 * SC_TC * 64, *Lr = L + 4 * SC_TC * 64, *Lv = L + 5 * SC_TC * 64, *Ly = L + 6 * SC_TC * 64;
    const int tid = F.tid, row = tid >> 3, jg = tid & 7;
    for (int bh = F.vcu; bh < NBATCH * 8; bh += F.G) {
        const int b = bh >> 3, h = bh & 7;
        float S[8];
#pragma unroll
        for (int e = 0; e < 8; ++e) S[e] = 0.f;
        for (int c0 = 0; c0 < SEQ; c0 += SC_TC) {
#pragma unroll
            for (int q = 0; q < 4; ++q) { const int e = tid + 512 * q, tt = e >> 6, j = e & 63; const size_t m = (size_t)b * SEQ + c0 + tt; const int col = h * 64 + j; const size_t off = m * 512 + col;
                const float rv = bf_lo((unsigned)RR[off]), kv = bf_lo((unsigned)KK[off]), vv = bf_lo((unsigned)VV[off]), av = bf_lo((unsigned)AA[off]);
                const float kkv = kv * k_k[col] * INV[m * 8 + h];
                Ldec[e] = DEC[off]; Lkk[e] = kkv; Lbet[e] = kkv * av; Lkp[e] = kv * (1.0f + (av - 1.0f) * k_a[col]); Lr[e] = rv; Lv[e] = vv; }
            __syncthreads();
            for (int tt = 0; tt < SC_TC; ++tt) {
                const LAS f32x4* pk = (const LAS f32x4*)(Lkk + tt * 64 + jg * 8); const f32x4 k0 = pk[0], k1 = pk[1];
                float sa = S[0] * k0.x + S[1] * k0.y + S[2] * k0.z + S[3] * k0.w + S[4] * k1.x + S[5] * k1.y + S[6] * k1.z + S[7] * k1.w;
                sa += __shfl_xor(sa, 1); sa += __shfl_xor(sa, 2); sa += __shfl_xor(sa, 4); sa = -sa;
                const float vr = Lv[tt * 64 + row];
                const LAS f32x4* pd = (const LAS f32x4*)(Ldec + tt * 64 + jg * 8); const f32x4 d0 = pd[0], d1 = pd[1];
                const LAS f32x4* pb = (const LAS f32x4*)(Lbet + tt * 64 + jg * 8); const f32x4 b0 = pb[0], b1 = pb[1];
                const LAS f32x4* pp = (const LAS f32x4*)(Lkp + tt * 64 + jg * 8); const f32x4 p0 = pp[0], p1 = pp[1];
                S[0] = S[0] * d0.x + sa * b0.x + vr * p0.x; S[1] = S[1] * d0.y + sa * b0.y + vr * p0.y; S[2] = S[2] * d0.z + sa * b0.z + vr * p0.z; S[3] = S[3] * d0.w + sa * b0.w + vr * p0.w;
                S[4] = S[4] * d1.x + sa * b1.x + vr * p1.x; S[5] = S[5] * d1.y + sa * b1.y + vr * p1.y; S[6] = S[6] * d1.z + sa * b1.z + vr * p1.z; S[7] = S[7] * d1.w + sa * b1.w + vr * p1.w;
                const LAS f32x4* pr = (const LAS f32x4*)(Lr + tt * 64 + jg * 8); const f32x4 r0 = pr[0], r1 = pr[1];
                float y = S[0] * r0.x + S[1] * r0.y + S[2] * r0.z + S[3] * r0.w + S[4] * r1.x + S[5] * r1.y + S[6] * r1.z + S[7] * r1.w;
                y += __shfl_xor(y, 1); y += __shfl_xor(y, 2); y += __shfl_xor(y, 4);
                if (jg == 0) Ly[tt * 64 + row] = y;
            }
            __syncthreads();
            { const int tt = tid >> 4, part = tid & 15, j0 = part * 4; const size_t m = (size_t)b * SEQ + c0 + tt; const int col = h * 64 + j0;
              const f32x4 y4 = *(const LAS f32x4*)(Ly + tt * 64 + j0);
              float s = (y4.x + y4.y) + (y4.z + y4.w); s += __shfl_xor(s, 1); s += __shfl_xor(s, 2); s += __shfl_xor(s, 4); s += __shfl_xor(s, 8);
              const float mean = s * (1.0f / 64.0f); const f32x4 dd = y4 - mean;
              float q2 = (dd.x * dd.x + dd.y * dd.y) + (dd.z * dd.z + dd.w * dd.w); q2 += __shfl_xor(q2, 1); q2 += __shfl_xor(q2, 2); q2 += __shfl_xor(q2, 4); q2 += __shfl_xor(q2, 8);
              const float rstd = 1.0f / sqrtf(q2 * (1.0f / 64.0f) + LNX_EPS);
              const f32x4 r4 = *(const LAS f32x4*)(Lr + tt * 64 + j0), kp4 = *(const LAS f32x4*)(Lkp + tt * 64 + j0), v4 = *(const LAS f32x4*)(Lv + tt * 64 + j0);
              const f32x4 rk4 = *(const f32x4*)(r_k + col);
              float bs = (r4.x * kp4.x * rk4.x + r4.y * kp4.y * rk4.y) + (r4.z * kp4.z * rk4.z + r4.w * kp4.w * rk4.w);
              bs += __shfl_xor(bs, 1); bs += __shfl_xor(bs, 2); bs += __shfl_xor(bs, 4); bs += __shfl_xor(bs, 8);
              const f32x4 lg = *(const f32x4*)(lnx_g + col), lb = *(const f32x4*)(lnx_b + col);
              const pg8::u32x2 gw = *(const pg8::u32x2*)(GG + m * 512 + col);
              f32x4 ov = dd * rstd * lg + lb + v4 * bs;
              ov.x *= bf_lo(gw.x); ov.y *= bf_hi(gw.x); ov.z *= bf_lo(gw.y); ov.w *= bf_hi(gw.y);
              pg8::u32x2 w; w.x = pk2(ov.x, ov.y); w.y = pk2(ov.z, ov.w);
              *(pg8::u32x2*)(YB + m * 512 + col) = w; }
            __syncthreads();
        }
    }
}
__device__ __forceinline__ void p2d_combine(Frame& F, const Args& a) {
    unsigned char* ws = a.ws;
    const bf16* O = (const bf16*)(ws + WS_O); bf16* YA = (bf16*)(ws + WS_Q); const float* sg = a.in[9];
    const float lam = diff_lambda(a);
    const int gw = F.vcu * NWAVES + F.wave, NGW = F.G * NWAVES, lane = F.lane;
    const int h = lane >> 4, e0 = (lane & 15) * 8;
    const f32x4 g0 = *(const f32x4*)(sg + e0), g1 = *(const f32x4*)(sg + e0 + 4);
    for (int m = gw; m < MTOK; m += NGW) {
        const v4u w0 = *(const v4u*)(O + (size_t)m * 1024 + (h * 2) * 128 + e0), w1 = *(const v4u*)(O + (size_t)m * 1024 + (h * 2 + 1) * 128 + e0);
        float d[8] = { bf_lo(w0.x) - lam * bf_lo(w1.x), bf_hi(w0.x) - lam * bf_hi(w1.x), bf_lo(w0.y) - lam * bf_lo(w1.y), bf_hi(w0.y) - lam * bf_hi(w1.y),
                       bf_lo(w0.z) - lam * bf_lo(w1.z), bf_hi(w0.z) - lam * bf_hi(w1.z), bf_lo(w0.w) - lam * bf_lo(w1.w), bf_hi(w0.w) - lam * bf_hi(w1.w) };
        float ss = 0.f;
#pragma unroll
        for (int e = 0; e < 8; ++e) ss += d[e] * d[e];
        ss += __shfl_xor(ss, 1); ss += __shfl_xor(ss, 2); ss += __shfl_xor(ss, 4); ss += __shfl_xor(ss, 8);
        const float r = 0.8f / sqrtf(ss * (1.0f / 128.0f) + LN_EPS);
        v4u o; o.x = pk2(d[0] * r * g0.x, d[1] * r * g0.y); o.y = pk2(d[2] * r * g0.z, d[3] * r * g0.w); o.z = pk2(d[4] * r * g1.x, d[5] * r * g1.y); o.w = pk2(d[6] * r * g1.z, d[7] * r * g1.w);
        *(v4u*)(YA + (size_t)m * 512 + h * 128 + e0) = o;
    }
}
__device__ __forceinline__ void ln_pass(Frame& F, float* Z, const float* g, const float* b, bf16* obf) {
    const int gw = F.vcu * NWAVES + F.wave, NGW = F.G * NWAVES;
    for (int m = gw; m < MTOK; m += NGW) ln_row(Z + (size_t)m * DM, g, b, Z + (size_t)m * DM, obf ? obf + (size_t)m * DM : nullptr, nullptr, F.lane);
}

constexpr int NPHASE = 12;
__global__ void __launch_bounds__(NWAVES * 64, 2) fwd_kernel(Args args) {
    extern __shared__ __attribute__((aligned(16))) unsigned char lds[];
    Frame F;
    F.lds = (LAS unsigned char*)lds;
    F.MISC = (volatile LAS unsigned*)(F.lds + MISC_OFF);
    F.tid = threadIdx.x; F.lane = F.tid & 63; F.wave = __builtin_amdgcn_readfirstlane(F.tid >> 6);
    F.G = gridDim.x; { const int bx = blockIdx.x; F.vcu = (F.G % 8 == 0) ? (bx % 8) * (F.G / 8) + bx / 8 : bx; }
    unsigned char* ws = args.ws;
    F.ctl = (gu32*)(ws + WS_CTL);
    for (int u = F.tid; u < (LDS_BYTES - LDSCTL_OFF) / 4; u += NWAVES * 64) ((LAS unsigned*)(F.lds + LDSCTL_OFF))[u] = 0u;
    __syncthreads();
#if MK_ONE_LAUNCH
    XcdBarrier bar = xcd_barrier_post((unsigned*)(F.ctl + CW_BAR), F.MISC + 8);
#define GRID_BAR() xcd_barrier(bar)
#else
#define GRID_BAR() do {} while (0)
#endif
    const int lo = args.ph_lo, hi = args.ph_hi;
#define IN(k) (lo <= (k) && (k) < hi)
#define BOTH(k) (IN(k) && IN((k) + 1))
    typedef pg8::bf16_t pb;
    if (IN(0)) { p0_prologue(F, args); if (BOTH(0)) GRID_BAR(); }
    if (IN(1)) {
        pg8::Gemm g{(const pb*)(ws + WS_HN), (const pb*)(ws + WS_WIN), MTOK, NPROJ, DM}; pg8::StaticOrder S; S.init(MTOK, NPROJ, F.G, (int)blockIdx.x);
        pg8::EpiProj E{(pb*)(ws + WS_Q), (pb*)(ws + WS_RW), (pb*)args.out};
        pg8::gemm_phase<pg8::EpiProj, pg8::StaticOrder, true, true>(F.lds + RING_OFF, g, S, E);
        if (BOTH(1)) GRID_BAR();
    }
    if (IN(2)) { p2a_shift(F, args); if (BOTH(2)) GRID_BAR(); }
    if (IN(3)) {
        pg8::Gemm g{(const pb*)(ws + WS_A2), (const pb*)(ws + WS_B2), MTOK, 1536, 256}; pg8::StaticOrder S; S.init(MTOK, 1536, F.G, (int)blockIdx.x);
        pg8::EpiLowrank E{(float*)(ws + WS_DEC), (pb*)(ws + WS_AA), (WS_GG - WS_AA) / 2, args.in[11], args.in[13]};
        pg8::gemm_phase<pg8::EpiLowrank, pg8::StaticOrder, true, true>(F.lds + RING_OFF, g, S, E);
        if (BOTH(3)) GRID_BAR();
    }
    if (IN(4)) { attn_naive(F, args); scan_phase(F, args); if (BOTH(4)) GRID_BAR(); }
    if (IN(5)) { p2d_combine(F, args); if (BOTH(5)) GRID_BAR(); }
    if (IN(6)) {
        { pg8::Gemm g{(const pb*)(ws + WS_Q), (const pb*)(ws + WS_WUPA), MTOK, DM, 512}; pg8::StaticOrder S; S.init(MTOK, DM, F.G, (int)blockIdx.x);
          pg8::EpiUp<0> E{(const pb*)args.out, (pb*)(ws + WS_T)};
          pg8::gemm_phase<pg8::EpiUp<0>, pg8::StaticOrder, true, true>(F.lds + RING_OFF, g, S, E); }
        asm volatile("s_waitcnt vmcnt(0)" ::: "memory"); __syncthreads();
        { pg8::Gemm g{(const pb*)(ws + WS_YB), (const pb*)(ws + WS_WUPB), MTOK, DM, 512}; pg8::StaticOrder S; S.init(MTOK, DM, F.G, (int)blockIdx.x);
          pg8::EpiUp<1> E{(const pb*)args.out, (pb*)(ws + WS_T)};
          pg8::gemm_phase<pg8::EpiUp<1>, pg8::StaticOrder, true, true>(F.lds + RING_OFF, g, S, E); }
        if (BOTH(6)) GRID_BAR();
    }
    if (IN(7)) {
        pg8::Gemm g{(const pb*)(ws + WS_T), (const pb*)(ws + WS_WOUT), MTOK, DM, DM}; pg8::StaticOrder S; S.init(MTOK, DM, F.G, (int)blockIdx.x);
        pg8::EpiOutZ E{args.in[0], (const float*)(ws + WS_STATS), args.in[1], args.in[2], args.out};
        pg8::gemm_phase<pg8::EpiOutZ, pg8::StaticOrder, true, true>(F.lds + RING_OFF, g, S, E);
        if (BOTH(7)) GRID_BAR();
    }
    if (IN(8)) { ln_pass(F, args.out, args.in[24], args.in[25], (bf16*)(ws + WS_H1B)); if (BOTH(8)) GRID_BAR(); }
    if (IN(9)) {
        pg8::Gemm g{(const pb*)(ws + WS_H1B), (const pb*)(ws + WS_WGU), MTOK, 2 * FFH, DM}; pg8::StaticOrder S; S.init(MTOK, 2 * FFH, F.G, (int)blockIdx.x);
        pg8::EpiSwiglu E{(pb*)(ws + WS_ACT)};
        pg8::gemm_phase<pg8::EpiSwiglu, pg8::StaticOrder, true, true>(F.lds + RING_OFF, g, S, E);
        if (BOTH(9)) GRID_BAR();
    }
    if (IN(10)) {
        pg8::Gemm g{(const pb*)(ws + WS_ACT), (const pb*)(ws + WS_WDN), MTOK, DM, FFH}; pg8::StaticOrder S; S.init(MTOK, DM, F.G, (int)blockIdx.x);
        pg8::EpiDownZ E{args.out};
        pg8::gemm_phase<pg8::EpiDownZ, pg8::StaticOrder, true, true>(F.lds + RING_OFF, g, S, E);
        if (BOTH(10)) GRID_BAR();
    }
    if (IN(11)) { ln_pass(F, args.out, args.in[29], args.in[30], nullptr); }
#undef IN
#undef BOTH
}

extern "C" void kernel_launch(void* const* d_in, const int* in_sizes, int n_in, void* d_out, int out_size, void* d_ws, size_t ws_size, hipStream_t stream) {
    static int grid = 0;
    if (grid == 0) {
        if (n_in != 31 || in_sizes[0] != MTOK * DM || out_size != MTOK * DM || ws_size < WS_END) { fprintf(stderr, "kernel_launch: unexpected shapes (n_in %d, in0 %d, out %d, ws %zu); nothing launched\n", n_in, n_in > 0 ? in_sizes[0] : -1, out_size, ws_size); grid = -1; return; }
        int dev = 0, cus = 0, per_cu = 0;
        if (hipGetDevice(&dev) != hipSuccess || hipDeviceGetAttribute(&cus, hipDeviceAttributeMultiprocessorCount, dev) != hipSuccess) { grid = -1; return; }
        if (hipFuncSetAttribute((const void*)fwd_kernel, hipFuncAttributeMaxDynamicSharedMemorySize, LDS_BYTES) != hipSuccess) { fprintf(stderr, "kernel_launch: hipFuncSetAttribute failed\n"); grid = -1; return; }
        if (hipOccupancyMaxActiveBlocksPerMultiprocessor(&per_cu, (const void*)fwd_kernel, NWAVES * 64, LDS_BYTES) != hipSuccess || per_cu < 1) { fprintf(stderr, "kernel_launch: occupancy query reports %d blocks per CU\n", per_cu); per_cu = 1; }
        (void)hipGetLastError();
        grid = cus;
    }
    if (grid < 0) return;
    if (hipMemsetAsync((char*)d_ws + WS_CTL, 0, CTL_ZERO_BYTES, stream) != hipSuccess) return;
    Args a{};
    for (int i = 0; i < 31; ++i) a.in[i] = (const float*)d_in[i];
    a.out = (float*)d_out; a.ws = (unsigned char*)d_ws;
#if MK_ONE_LAUNCH
    a.ph_lo = 0; a.ph_hi = NPHASE;
    hipLaunchKernelGGL(fwd_kernel, dim3(grid), dim3(NWAVES * 64), LDS_BYTES, stream, a);
#else
    for (int p = 0; p < NPHASE; ++p) { a.ph_lo = p; a.ph_hi = p + 1; hipLaunchKernelGGL(fwd_kernel, dim3(grid), dim3(NWAVES * 64), LDS_BYTES, stream, a); }
#endif
}
```

```cpp
#include <hip/hip_runtime.h>
#include <cstdio>
#include <cstdint>
#include <cmath>

#ifndef MK_ONE_LAUNCH
#define MK_ONE_LAUNCH 1
#endif

constexpr int MTOK = 32768, DM = 1024, SEQ = 2048, NBATCH = 16;
constexpr int NPROJ = 5376, FFH = 2816;
constexpr float C2 = 0.125f * 1.4426950408889634f;
constexpr float LOG2E = 1.4426950408889634f;
constexpr float ALPHA = 1.189207115002721f;
constexpr float LN_EPS = 1e-5f, LNX_EPS = 64e-5f;

namespace pg8 {
#define PG8_LAS __attribute__((address_space(3)))
typedef unsigned short bf16_t;
typedef short bf16x8 __attribute__((ext_vector_type(8)));
typedef float f32x4 __attribute__((ext_vector_type(4)));
typedef unsigned u32x4 __attribute__((ext_vector_type(4)));
constexpr int BM = 256, BK = 64, HALF = 128, HTB = HALF * BK * 2  , STAGE_BYTES = 8 * HTB, NXCD = 8, WGM = 8;

__host__ __device__ __forceinline__ int lds_byte(int r, int c) { const int st = (r >> 4) * 2 + (c >> 5), rr = r & 15, cc = c & 31, ob = rr * 64 + cc * 2; return st * 1024 + (ob ^ (((ob >> 9) & 1) << 5)); }
__host__ __device__ __forceinline__ void stage_rc(int b, int& R, int& C) { const int st = b / 1024, sb = b % 1024, swz = sb ^ (((sb >> 9) & 1) << 5); R = (st >> 1) * 16 + swz / 64; C = (st & 1) * 32 + (swz % 64) / 2; }
__host__ __device__ __forceinline__ int perm32(int rho) { const int n = rho >> 4, i = rho & 15; return 8 * (i >> 2) + 4 * n + (i & 3); }

struct Unit { int pm, pn; };
struct Gemm { const bf16_t* A; const bf16_t* Bt; int M, N, K; };

struct StaticOrder {
    int nM, nN, nwg, G, c;
    __host__ __device__ void init(int M, int N, int G_, int c_) { nM = M / BM; nN = N / BM; nwg = nM * nN; G = G_; c = c_; }
    __host__ __device__ bool next(int i, Unit& u) const {
        const long L = (long)i * G + c; if (L >= nwg) return false;
        int wgid = (int)L; { const int q = nwg / NXCD, r = nwg % NXCD, xcd = wgid % NXCD, off = wgid / NXCD; wgid = (xcd < r ? xcd * (q + 1) : r * (q + 1) + (xcd - r) * q) + off; }
        const int nig = WGM * nN, gid = wgid / nig, fm = gid * WGM, gsz = (nM - fm) < WGM ? (nM - fm) : WGM;
        u.pm = fm + ((wgid % nig) % gsz); u.pn = (wgid % nig) / gsz; return true;
    }
    __device__ __forceinline__ void a_ready(const Unit&) const {}
    __device__ __forceinline__ void done(const Unit&) const {}
};

__device__ __forceinline__ unsigned cvt_pk_bf16(float lo, float hi) { unsigned r; asm volatile("v_cvt_pk_bf16_f32 %0, %1, %2" : "=v"(r) : "v"(lo), "v"(hi)); return r; }
__device__ __forceinline__ float bf_lo(unsigned w) { return __builtin_bit_cast(float, w << 16); }
__device__ __forceinline__ float bf_hi(unsigned w) { return __builtin_bit_cast(float, w & 0xffff0000u); }
__device__ __forceinline__ float sigmoid_f(float x) { return __builtin_amdgcn_rcpf(1.0f + __builtin_amdgcn_exp2f(-x * 1.4426950408889634f)); }
typedef unsigned u32x2 __attribute__((ext_vector_type(2)));
struct EpiProj {
    static constexpr bool PERM = true, AFTER_DRAIN = false;
    bf16_t* Q; bf16_t* RW; bf16_t* GT;
    __device__ __forceinline__ void operator()(const f32x4 (&acc)[2][2][4][2], const Unit& u, int wr, int wc, int fr, int fq) const {
        const int row0 = u.pm * BM + wr * 64 + fr; const int colt = u.pn * BM;
        bf16_t* base; int ldc, c0; float sc = 1.f; bool sig = false;
        if (colt < 1536) { const int t = colt >> 9; base = Q + (size_t)t * ((size_t)MTOK * 512); ldc = 512; c0 = colt & 511; if (t == 0) sc = C2; }
        else if (colt < 3328) { base = RW; ldc = 1792; c0 = colt - 1536; }
        else { base = GT; ldc = 2048; c0 = colt - 3328; sig = true; }
        const int col0 = c0 + wc * 32 + 8 * fq;
#pragma unroll
        for (int ai = 0; ai < 2; ++ai)
#pragma unroll
            for (int m = 0; m < 4; ++m) { bf16_t* rowp = base + (size_t)(row0 + ai * HALF + m * 16) * ldc + col0;
#pragma unroll
                for (int bj = 0; bj < 2; ++bj) { f32x4 v0 = acc[ai][bj][m][0], v1 = acc[ai][bj][m][1];
                    if (sig) {
#pragma unroll
                        for (int e = 0; e < 4; ++e) { v0[e] = sigmoid_f(v0[e]); v1[e] = sigmoid_f(v1[e]); } }
                    else { v0 = v0 * sc; v1 = v1 * sc; }
                    u32x4 w; w.x = cvt_pk_bf16(v0[0], v0[1]); w.y = cvt_pk_bf16(v0[2], v0[3]); w.z = cvt_pk_bf16(v1[0], v1[1]); w.w = cvt_pk_bf16(v1[2], v1[3]);
                    *(u32x4*)(rowp + bj * HALF) = w; } }
    }
};
struct EpiLowrank {
    static constexpr bool PERM = false, AFTER_DRAIN = false;
    float* DEC; bf16_t* AA; size_t GGOFF; const float* w0; const float* a0;
    __device__ __forceinline__ void operator()(const f32x4 (&acc)[2][2][4][2], const Unit& u, int wr, int wc, int fr, int fq) const {
        const int row0 = u.pm * BM + wr * 64 + fr; const int colt = u.pn * BM; const int kind = colt >> 9;
        const int cb = (colt & 511) + wc * 32 + 4 * fq;
        bf16_t* dst16 = AA + (kind == 2 ? GGOFF : (size_t)0);
#pragma unroll
        for (int bj = 0; bj < 2; ++bj)
#pragma unroll
            for (int n = 0; n < 2; ++n) { const int c = cb + bj * HALF + n * 16;
                f32x4 bv = (f32x4){0.f, 0.f, 0.f, 0.f};
                if (kind == 0) bv = *(const f32x4*)(w0 + c); else if (kind == 1) bv = *(const f32x4*)(a0 + c);
#pragma unroll
                for (int ai = 0; ai < 2; ++ai)
#pragma unroll
                    for (int m = 0; m < 4; ++m) { const size_t off = (size_t)(row0 + ai * HALF + m * 16) * 512 + c; f32x4 v = acc[ai][bj][m][n] + bv;
                        if (kind == 0) {
#pragma unroll
                            for (int e = 0; e < 4; ++e) { const float y = -v[e];
                                const float sp = fmaxf(y, 0.f) + 0.6931471805599453f * __builtin_amdgcn_logf(1.0f + __builtin_amdgcn_exp2f(-fabsf(y) * LOG2E));
                                const float lam = __builtin_amdgcn_exp2f((-sp - 0.5f) * LOG2E); v[e] = __builtin_amdgcn_exp2f(-lam * LOG2E); }
                            *(f32x4*)(DEC + off) = v;
                        } else {
                            if (kind == 1) {
#pragma unroll
                                for (int e = 0; e < 4; ++e) v[e] = sigmoid_f(v[e]); }
                            u32x2 w; w.x = cvt_pk_bf16(v[0], v[1]); w.y = cvt_pk_bf16(v[2], v[3]);
                            *(u32x2*)(dst16 + off) = w; } } }
    }
};
template <int WHICH> struct EpiUp {
    static constexpr bool PERM = true, AFTER_DRAIN = false;
    const bf16_t* GT; bf16_t* T;
    __device__ __forceinline__ void operator()(const f32x4 (&acc)[2][2][4][2], const Unit& u, int wr, int wc, int fr, int fq) const {
        const int row0 = u.pm * BM + wr * 64 + fr; const int col0 = u.pn * BM + wc * 32 + 8 * fq;
#pragma unroll
        for (int ai = 0; ai < 2; ++ai)
#pragma unroll
            for (int m = 0; m < 4; ++m) { const size_t row = (size_t)(row0 + ai * HALF + m * 16);
#pragma unroll
                for (int bj = 0; bj < 2; ++bj) { const int c = col0 + bj * HALF;
                    const u32x4 g = *(const u32x4*)(GT + row * 2048 + WHICH * 1024 + c);
                    const f32x4 v0 = acc[ai][bj][m][0], v1 = acc[ai][bj][m][1];
                    float r[8] = { bf_lo(g.x) * v0[0], bf_hi(g.x) * v0[1], bf_lo(g.y) * v0[2], bf_hi(g.y) * v0[3], bf_lo(g.z) * v1[0], bf_hi(g.z) * v1[1], bf_lo(g.w) * v1[2], bf_hi(g.w) * v1[3] };
                    if (WHICH == 1) { const u32x4 t = *(const u32x4*)(T + row * 1024 + c);
                        r[0] += bf_lo(t.x); r[1] += bf_hi(t.x); r[2] += bf_lo(t.y); r[3] += bf_hi(t.y); r[4] += bf_lo(t.z); r[5] += bf_hi(t.z); r[6] += bf_lo(t.w); r[7] += bf_hi(t.w); }
                    u32x4 w; w.x = cvt_pk_bf16(r[0], r[1]); w.y = cvt_pk_bf16(r[2], r[3]); w.z = cvt_pk_bf16(r[4], r[5]); w.w = cvt_pk_bf16(r[6], r[7]);
                    *(u32x4*)(T + row * 1024 + c) = w; } }
    }
};
struct EpiOutZ {
    static constexpr bool PERM = false, AFTER_DRAIN = false;
    const float* x; const float* stats; const float* g_in; const float* b_in; float* Z;
    __device__ __forceinline__ void operator()(const f32x4 (&acc)[2][2][4][2], const Unit& u, int wr, int wc, int fr, int fq) const {
        const int row0 = u.pm * BM + wr * 64 + fr; const int cb = u.pn * BM + wc * 32 + 4 * fq;
#pragma unroll
        for (int bj = 0; bj < 2; ++bj)
#pragma unroll
            for (int n = 0; n < 2; ++n) { const int c = cb + bj * HALF + n * 16; const f32x4 gi = *(const f32x4*)(g_in + c), bi = *(const f32x4*)(b_in + c);
#pragma unroll
                for (int ai = 0; ai < 2; ++ai)
#pragma unroll
                    for (int m = 0; m < 4; ++m) { const size_t row = (size_t)(row0 + ai * HALF + m * 16); const float mean = stats[row * 2], rstd = stats[row * 2 + 1];
                        const f32x4 xv = *(const f32x4*)(x + row * 1024 + c); const f32x4 h = (xv - mean) * rstd * gi + bi;
                        *(f32x4*)(Z + row * 1024 + c) = h * ALPHA + acc[ai][bj][m][n]; } }
    }
};
struct EpiSwiglu {
    static constexpr bool PERM = true, AFTER_DRAIN = false;
    bf16_t* ACT;
    __device__ __forceinline__ void operator()(const f32x4 (&acc)[2][2][4][2], const Unit& u, int wr, int wc, int fr, int fq) const {
        const int row0 = u.pm * BM + wr * 64 + fr; const int col0 = u.pn * HALF + wc * 32 + 8 * fq;
#pragma unroll
        for (int ai = 0; ai < 2; ++ai)
#pragma unroll
            for (int m = 0; m < 4; ++m) { const size_t row = (size_t)(row0 + ai * HALF + m * 16);
                float r[8];
#pragma unroll
                for (int n = 0; n < 2; ++n)
#pragma unroll
                    for (int e = 0; e < 4; ++e) { const float g = acc[ai][0][m][n][e], up = acc[ai][1][m][n][e]; r[4 * n + e] = g * sigmoid_f(g) * up; }
                u32x4 w; w.x = cvt_pk_bf16(r[0], r[1]); w.y = cvt_pk_bf16(r[2], r[3]); w.z = cvt_pk_bf16(r[4], r[5]); w.w = cvt_pk_bf16(r[6], r[7]);
                *(u32x4*)(ACT + row * FFH + col0) = w; }
    }
};
struct EpiDownZ {
    static constexpr bool PERM = false, AFTER_DRAIN = false;
    float* Z;
    __device__ __forceinline__ void operator()(const f32x4 (&acc)[2][2][4][2], const Unit& u, int wr, int wc, int fr, int fq) const {
        const int row0 = u.pm * BM + wr * 64 + fr; const int cb = u.pn * BM + wc * 32 + 4 * fq;
#pragma unroll
        for (int ai = 0; ai < 2; ++ai)
#pragma unroll
            for (int m = 0; m < 4; ++m) { const size_t row = (size_t)(row0 + ai * HALF + m * 16);
#pragma unroll
                for (int bj = 0; bj < 2; ++bj)
#pragma unroll
                    for (int n = 0; n < 2; ++n) { float* p = Z + row * 1024 + cb + bj * HALF + n * 16; const f32x4 h = *(const f32x4*)p; *(f32x4*)p = h * ALPHA + acc[ai][bj][m][n]; } }
    }
};

template <class Epi, class Sched, bool ALIGN_EPI = false, bool SP2 = false>
__device__ __forceinline__ void gemm_phase(PG8_LAS unsigned char* lds, const Gemm g, const Sched& S, const Epi& E) {
    const int tid = threadIdx.x, wid = __builtin_amdgcn_readfirstlane(tid >> 6), lane = tid & 63, wr = wid >> 2, wc = wid & 3, fr = lane & 15, fq = lane >> 4;
    const int K = g.K, nt = K / BK;
    unsigned voffA[2], voffB[2];
#pragma unroll
    for (int i = 0; i < 2; ++i) { int R, C; stage_rc(tid * 16 + i * 8192, R, C); const int Rb = Epi::PERM ? ((R & ~31) + perm32(R & 31)) : R;
        voffA[i] = (unsigned)(R * K + C) * 2u; voffB[i] = (unsigned)(Rb * K + C) * 2u; }
    const size_t kstep = (size_t)(BK * 2);
    const size_t hstep = (size_t)HALF * K * 2;
    const size_t tstep = 2 * hstep;
    const unsigned ldsw = (unsigned)wid * 1024u;
    const int aoff = lds_byte(wr * 64 + fr, fq * 8), boff = lds_byte(wc * 32 + fr, fq * 8);
#define PG8_SA(b, h) (((b) * 2 + (h)) * HTB)
#define PG8_SB(b, h) ((4 + (b) * 2 + (h)) * HTB)
#define PG8_STAGE(bufoff, gbase, voff) do { _Pragma("unroll") for (int _i = 0; _i < 2; ++_i) \
        __builtin_amdgcn_global_load_lds((const unsigned*)((const char*)(gbase) + (voff)[_i]), (PG8_LAS unsigned*)(lds + (bufoff) + ldsw + _i * 8192), 16, 0, 0); } while (0)
#define PG8_LDA(dst, b, h) do { _Pragma("unroll") for (int m = 0; m < 4; ++m) _Pragma("unroll") for (int k = 0; k < 2; ++k) dst[m][k] = *(const PG8_LAS bf16x8*)(lds + PG8_SA(b, h) + aoff + m * 2048 + k * 1024); } while (0)
#define PG8_LDB(dst, b, h) do { _Pragma("unroll") for (int n = 0; n < 2; ++n) _Pragma("unroll") for (int k = 0; k < 2; ++k) dst[n][k] = *(const PG8_LAS bf16x8*)(lds + PG8_SB(b, h) + boff + n * 2048 + k * 1024); } while (0)
#define PG8_MMA(ai, bj, At, Bt) do { __builtin_amdgcn_s_setprio(1); _Pragma("unroll") for (int m = 0; m < 4; ++m) _Pragma("unroll") for (int n = 0; n < 2; ++n) _Pragma("unroll") for (int k = 0; k < 2; ++k) \
        acc[ai][bj][m][n] = __builtin_amdgcn_mfma_f32_16x16x32_bf16(Bt[n][k], At[m][k], acc[ai][bj][m][n], 0, 0, 0); __builtin_amdgcn_s_setprio(0); } while (0)
#define PG8_WAIT_V(n) asm volatile("s_waitcnt vmcnt(" #n ")" ::: "memory")
#define PG8_WAIT_L(n) asm volatile("s_waitcnt lgkmcnt(" #n ")" ::: "memory")
#define PG8_BAR __builtin_amdgcn_s_barrier()
#define PG8_SCHED __builtin_amdgcn_sched_barrier(0)
    Unit cur, nxt; int ui = 0;
    if (!S.next(0, cur)) return;
    f32x4 acc[2][2][4][2];
#pragma unroll
    for (int a = 0; a < 2; ++a)
#pragma unroll
        for (int b = 0; b < 2; ++b)
#pragma unroll
            for (int m = 0; m < 4; ++m)
#pragma unroll
                for (int n = 0; n < 2; ++n) acc[a][b][m][n] = (f32x4){0.f, 0.f, 0.f, 0.f};
    bf16x8 At[4][2], B0[2][2], B1[2][2];
    const char* cA = (const char*)g.A + (size_t)cur.pm * tstep; const char* cB = (const char*)g.Bt + (size_t)cur.pn * tstep;
    S.a_ready(cur);
    if constexpr (SP2) {
        PG8_STAGE(PG8_SB(0, 0), cB, voffB); PG8_STAGE(PG8_SB(0, 1), cB + hstep, voffB); PG8_STAGE(PG8_SA(0, 0), cA, voffA); PG8_STAGE(PG8_SA(0, 1), cA + hstep, voffA);
        if (wr == 1) PG8_BAR;
        PG8_WAIT_V(2); PG8_BAR;
        PG8_STAGE(PG8_SB(1, 0), cB + kstep, voffB); PG8_STAGE(PG8_SA(1, 0), cA + kstep, voffA); PG8_STAGE(PG8_SB(1, 1), cB + hstep + kstep, voffB);
        PG8_WAIT_V(6); PG8_BAR;
    } else {
        PG8_STAGE(PG8_SB(0, 0), cB, voffB); PG8_STAGE(PG8_SA(0, 0), cA, voffA); PG8_STAGE(PG8_SB(0, 1), cB + hstep, voffB); PG8_STAGE(PG8_SA(0, 1), cA + hstep, voffA);
        if (wr == 1) PG8_BAR;
        PG8_WAIT_V(4); PG8_BAR;
        PG8_STAGE(PG8_SB(1, 0), cB + kstep, voffB); PG8_STAGE(PG8_SA(1, 0), cA + kstep, voffA); PG8_STAGE(PG8_SB(1, 1), cB + hstep + kstep, voffB);
        PG8_WAIT_V(6); PG8_BAR;
    }
    for (;;) {
        const bool has_next = S.next(ui + 1, nxt);
        const char* nA = has_next ? (const char*)g.A + (size_t)nxt.pm * tstep : cA; const char* nB = has_next ? (const char*)g.Bt + (size_t)nxt.pn * tstep : cB;
        for (int t = 0; t < nt; t += 2) {
            const bool last = (t == nt - 2);
            const char* a1 = cA + (size_t)(t + 1) * kstep;
            const char* a2 = last ? nA : cA + (size_t)(t + 2) * kstep; const char* b2 = last ? nB : cB + (size_t)(t + 2) * kstep;
            const char* a3 = a2 + kstep; const char* b3 = b2 + kstep;
            if (last && has_next) S.a_ready(nxt);
            if constexpr (SP2) {
            PG8_LDB(B0, 0, 0); PG8_LDB(B1, 0, 1); PG8_SCHED; PG8_LDA(At, 0, 0); PG8_STAGE(PG8_SA(1, 1), a1 + hstep, voffA);
            PG8_WAIT_V(8); PG8_WAIT_L(0); PG8_BAR; PG8_MMA(0, 0, At, B0); PG8_MMA(0, 1, At, B1); PG8_BAR; PG8_SCHED;
            PG8_LDA(At, 0, 1); PG8_STAGE(PG8_SB(0, 0), b2, voffB); PG8_STAGE(PG8_SB(0, 1), b2 + hstep, voffB); PG8_STAGE(PG8_SA(0, 0), a2, voffA);
            PG8_WAIT_V(8); PG8_WAIT_L(0); PG8_BAR; PG8_MMA(1, 0, At, B0); PG8_MMA(1, 1, At, B1); PG8_BAR; PG8_SCHED;
            PG8_LDB(B0, 1, 0); PG8_LDB(B1, 1, 1); PG8_SCHED; PG8_LDA(At, 1, 0); PG8_STAGE(PG8_SA(0, 1), a2 + hstep, voffA);
            PG8_WAIT_V(8); PG8_WAIT_L(0); PG8_BAR; PG8_MMA(0, 0, At, B0); PG8_MMA(0, 1, At, B1); PG8_BAR; PG8_SCHED;
            PG8_LDA(At, 1, 1); PG8_STAGE(PG8_SB(1, 0), b3, voffB); PG8_STAGE(PG8_SB(1, 1), b3 + hstep, voffB); PG8_STAGE(PG8_SA(1, 0), a3, voffA);
            PG8_WAIT_V(8); PG8_WAIT_L(0); PG8_BAR; PG8_MMA(1, 0, At, B0); PG8_MMA(1, 1, At, B1); PG8_BAR; PG8_SCHED;
            } else {
            PG8_LDB(B0, 0, 0); PG8_SCHED; PG8_LDA(At, 0, 0); PG8_STAGE(PG8_SA(1, 1), a1 + hstep, voffA);
            PG8_WAIT_L(8); PG8_BAR; PG8_WAIT_L(0); PG8_MMA(0, 0, At, B0); PG8_BAR; PG8_SCHED;
            PG8_LDB(B1, 0, 1); PG8_STAGE(PG8_SB(0, 0), b2, voffB);
            PG8_BAR; PG8_WAIT_L(0); PG8_MMA(0, 1, At, B1); PG8_BAR;
            PG8_LDA(At, 0, 1); PG8_STAGE(PG8_SA(0, 0), a2, voffA);
            PG8_BAR; PG8_WAIT_L(0); PG8_MMA(1, 0, At, B0); PG8_BAR; PG8_SCHED;
            PG8_STAGE(PG8_SB(0, 1), b2 + hstep, voffB);
            PG8_WAIT_V(6); PG8_BAR; PG8_MMA(1, 1, At, B1); PG8_BAR;
            PG8_LDB(B0, 1, 0); PG8_SCHED; PG8_LDA(At, 1, 0); PG8_STAGE(PG8_SA(0, 1), a2 + hstep, voffA);
            PG8_WAIT_L(8); PG8_BAR; PG8_WAIT_L(0); PG8_MMA(0, 0, At, B0); PG8_BAR; PG8_SCHED;
            PG8_LDB(B1, 1, 1); PG8_STAGE(PG8_SB(1, 0), b3, voffB);
            PG8_BAR; PG8_WAIT_L(0); PG8_MMA(0, 1, At, B1); PG8_BAR;
            PG8_LDA(At, 1, 1); PG8_STAGE(PG8_SA(1, 0), a3, voffA);
            PG8_BAR; PG8_WAIT_L(0); PG8_MMA(1, 0, At, B0); PG8_BAR; PG8_SCHED;
            PG8_STAGE(PG8_SB(1, 1), b3 + hstep, voffB);
            PG8_WAIT_V(6); PG8_BAR; PG8_MMA(1, 1, At, B1); PG8_BAR;
            }
        }
        if constexpr (ALIGN_EPI) { if (wr == 0) PG8_BAR; }
        if constexpr (!Epi::AFTER_DRAIN) { E(acc, cur, wr, wc, fr, fq); S.done(cur); }
        if (!has_next) break;
#pragma unroll
        for (int a = 0; a < 2; ++a)
#pragma unroll
            for (int b = 0; b < 2; ++b)
#pragma unroll
                for (int m = 0; m < 4; ++m)
#pragma unroll
                    for (int n = 0; n < 2; ++n) acc[a][b][m][n] = (f32x4){0.f, 0.f, 0.f, 0.f};
        cur = nxt; cA = nA; cB = nB; ++ui;
        if constexpr (ALIGN_EPI) { if (wr == 1) PG8_BAR; }
    }
    PG8_WAIT_V(0);
    if constexpr (!ALIGN_EPI) { if (wr == 0) PG8_BAR; }
    PG8_BAR;
    if constexpr (Epi::AFTER_DRAIN) { E.fused(acc, cur, wr, wc, fr, fq, lds, wid, lane); S.done(cur); }
#undef PG8_SA
#undef PG8_SB
#undef PG8_STAGE
#undef PG8_LDA
#undef PG8_LDB
#undef PG8_MMA
#undef PG8_WAIT_V
#undef PG8_WAIT_L
#undef PG8_BAR
#undef PG8_SCHED
}
}
constexpr int NWAVES = 8;
constexpr size_t MiB = 1u << 20;
constexpr size_t WS_CTL = 0, CTL_ZERO_BYTES = 1 * MiB;
constexpr size_t WS_STATS = 1 * MiB;
constexpr size_t WS_INVN = 1 * MiB + 512 * 1024;
constexpr size_t WS_WIN = 3 * MiB;
constexpr size_t WS_WUPA = WS_WIN + 10 * MiB + 512 * 1024;
constexpr size_t WS_WUPB = WS_WUPA + 1 * MiB;
constexpr size_t WS_WOUT = WS_WUPB + 1 * MiB;
constexpr size_t WS_WGU = WS_WOUT + 2 * MiB;
constexpr size_t WS_WDN = WS_WGU + 11 * MiB;
constexpr size_t WS_B2 = WS_WDN + 5 * MiB + 512 * 1024;
constexpr size_t WS_Q = 35 * MiB;
constexpr size_t WS_HN = 131 * MiB;
constexpr size_t WS_RR = 131 * MiB, WS_KK = 163 * MiB, WS_VV = 195 * MiB;
constexpr size_t WS_RW = 227 * MiB;
constexpr size_t WS_DEC = 227 * MiB, WS_AA = 291 * MiB;
constexpr size_t WS_A2 = 339 * MiB;
constexpr size_t WS_YB = 323 * MiB;
constexpr size_t WS_GG = 355 * MiB;
constexpr size_t WS_O = 387 * MiB;
constexpr size_t WS_YA = 451 * MiB;
constexpr size_t WS_T = 131 * MiB;
constexpr size_t WS_H1B = 195 * MiB;
constexpr size_t WS_ACT = 259 * MiB;
constexpr size_t WS_END = 483 * MiB;
static_assert(WS_B2 + 1536 * 256 * 2 <= WS_Q, "weights fit");
constexpr int CW_TMO = 0, CW_CODE = 1, CW_BAR = 4096;
constexpr int RING_OFF = 0, RING_BYTES = 131072;
constexpr int LDSCTL_OFF = RING_BYTES, MISC_OFF = LDSCTL_OFF + 320;
constexpr int LDS_BYTES = 147456;

#define GAS __attribute__((address_space(1)))
#define LAS __attribute__((address_space(3)))
typedef unsigned short bf16;
typedef unsigned v4u __attribute__((ext_vector_type(4)));
typedef float f32x4 __attribute__((ext_vector_type(4)));
typedef short bf16x8 __attribute__((ext_vector_type(8)));
typedef GAS unsigned gu32;
typedef GAS unsigned long long gu64;
#define RLX_AGENT __ATOMIC_RELAXED, __HIP_MEMORY_SCOPE_AGENT
#define LDS_WAIT() asm volatile("s_waitcnt lgkmcnt(0)" ::: "memory")
#define VM_WAIT() asm volatile("s_waitcnt vmcnt(0)" ::: "memory")
__device__ __forceinline__ unsigned long long rt() { return __builtin_amdgcn_s_memrealtime(); }
__device__ __forceinline__ unsigned f2bf(float f) { unsigned u = __builtin_bit_cast(unsigned, f); return (u + 0x7fffu + ((u >> 16) & 1u)) >> 16; }
__device__ __forceinline__ unsigned pk2(float lo, float hi) { return f2bf(lo) | (f2bf(hi) << 16); }

#define XB_TMO      128
#define XB_XCNT(j)  (256  + 64 * (j))
#define XB_XSUB(j)  (1280 + 64 * (j))
#define XB_XGEN(j)  (2304 + 64 * (j))
#define XB_TOP      3328
#define XB_TOPGEN   3392
#define XCD_BAR_WORDS 3456
#define XB_SPIN_CAP (1u << 18)

__device__ __forceinline__ unsigned xb_ld(unsigned* p)              { return __hip_atomic_load(p, __ATOMIC_RELAXED, __HIP_MEMORY_SCOPE_AGENT); }
__device__ __forceinline__ unsigned xb_add(unsigned* p, unsigned v) { return __hip_atomic_fetch_add(p, v, __ATOMIC_RELAXED, __HIP_MEMORY_SCOPE_AGENT); }
__device__ __forceinline__ unsigned xb_xcc_id() { return (unsigned)__builtin_amdgcn_s_getreg((3 << 11) | 20) & 0xFu; }
#define XB_SPIN(cond, bar) do { unsigned _sp = 0; while (cond) { __builtin_amdgcn_s_sleep(1); \
    if ((++_sp & 255u) == 0u) { if (xb_ld(&(bar)[XB_TMO])) break; if (_sp > XB_SPIN_CAP) { atomicAdd(&(bar)[XB_TMO], 1u); break; } } } } while (0)

struct XcdBarrier {
    unsigned* bar; unsigned x;
    volatile LAS unsigned* st;
};

__device__ __forceinline__ XcdBarrier xcd_barrier_post(unsigned* bar, volatile LAS unsigned* st) {
    XcdBarrier b; b.bar = bar; b.x = xb_xcc_id(); b.st = st;
    if (threadIdx.x == 0) (void)xb_add(&bar[XB_XCNT(b.x)], 1u);
    return b;
}
__device__ __forceinline__ void xcd_barrier_complete(unsigned* bar, unsigned x, unsigned& nloc, unsigned& nx) {
    const unsigned G = gridDim.x * gridDim.y * gridDim.z;
    unsigned sum, cnt, mine, sp = 0u;
    for (;;) {
        sum = 0u; cnt = 0u; mine = 0u;
#pragma unroll
        for (unsigned j = 0; j < 16; ++j) { const unsigned c = xb_ld(&bar[XB_XCNT(j)]); sum += c; cnt += (c > 0u) ? 1u : 0u; mine = (j == x) ? c : mine; }
        if (sum == G) break;
        __builtin_amdgcn_s_sleep(1);
        if ((++sp & 255u) == 0u) { if (xb_ld(&bar[XB_TMO])) break; if (sp > XB_SPIN_CAP) { atomicAdd(&bar[XB_TMO], 1u); break; } }
    }
    nloc = mine > 0u ? mine : 1u; nx = cnt > 0u ? cnt : 1u;
}

__device__ __forceinline__ void xcd_barrier(const XcdBarrier& b) {
    asm volatile("s_waitcnt vmcnt(0)" ::: "memory");
    __syncthreads();
    if (threadIdx.x == 0) {
        unsigned* bar = b.bar;
        __builtin_amdgcn_s_waitcnt(0);
        unsigned nloc = b.st[0], nx = b.st[1];
        if (nloc == 0u) { xcd_barrier_complete(bar, b.x, nloc, nx); b.st[0] = nloc; b.st[1] = nx; }
        const unsigned old = xb_add(&bar[XB_XSUB(b.x)], 1u);
        const unsigned gen = old / nloc;
        if (old + 1u == (gen + 1u) * nloc) {
            __builtin_amdgcn_fence(__ATOMIC_RELEASE, "agent");
            asm volatile("s_waitcnt vmcnt(0)" ::: "memory");
            const unsigned og = xb_add(&bar[XB_TOP], 1u);
            const unsigned tg = og / nx;
            if (og + 1u == (tg + 1u) * nx) xb_add(&bar[XB_TOPGEN], 1u);
            else XB_SPIN(xb_ld(&bar[XB_TOPGEN]) == tg, bar);
            __builtin_amdgcn_fence(__ATOMIC_ACQUIRE, "agent");
            xb_add(&bar[XB_XGEN(b.x)], 1u);
            asm volatile("s_waitcnt vmcnt(0)" ::: "memory");
        } else {
            XB_SPIN(xb_ld(&bar[XB_XGEN(b.x)]) == gen, bar);
            __builtin_amdgcn_fence(__ATOMIC_ACQUIRE, "agent");
            asm volatile("s_waitcnt vmcnt(0)" ::: "memory");
        }
    }
    __syncthreads();
}
namespace attn_body {
typedef unsigned short bf16;
using bf16x8=__attribute__((ext_vector_type(8)))short;
using s16x4=__attribute__((ext_vector_type(4)))short;
using f32x16=__attribute__((ext_vector_type(16)))float;
using u32x4=__attribute__((ext_vector_type(4)))unsigned;
constexpr int SEQ=2048,D=64,PQ=512,PO=1024;
constexpr int NW=8,QBLK=32,QB=QBLK*NW,KVBLK=64,NQB=SEQ/QB;
constexpr int ATTN_UNIT_ROWS=QB;
__device__ __forceinline__ int crow(int r,int hi){return (r&3)+8*(r>>2)+4*hi;}
#define SBAR() __builtin_amdgcn_sched_barrier(0)
typedef __attribute__((address_space(3))) const float* lds_cfp;
__device__ __forceinline__ void biasmask(f32x16&p0,f32x16&p1,int jb,int qrel,int hi,lds_cfp rt){
  const lds_cfp b=rt+(qrel-64*jb-4*hi+256);
  #pragma unroll
  for(int r=0;r<16;++r){const int c=(r&3)+8*(r>>2); p0[r]+=b[-c]; p1[r]+=b[-c-32];}
}
constexpr int NSLOT=3, SLOTB=8192;
constexpr int LDS_K=0, LDS_V=NSLOT*SLOTB, LDS_WS=2*NSLOT*SLOTB, LDS_OST=LDS_WS+NW*64*4, LDS_BYTES=LDS_OST+NW*4096;
constexpr float C2=0.125f*1.4426950408889634f;
__device__ __forceinline__ void glds16(const void*gsrc,unsigned lds_dst){unsigned keep;
  asm volatile("s_mov_b32 %0, m0\n\ts_mov_b32 m0, %2\n\ts_nop 0\n\tglobal_load_lds_dwordx4 %1, off\n\ts_mov_b32 m0, %0":"=&s"(keep):"v"(gsrc),"s"(lds_dst):"memory");}
__device__ __forceinline__ float max3f(float a,float b,float c){float r;asm("v_max3_f32 %0, %1, %2, %3":"=v"(r):"v"(a),"v"(b),"v"(c));return r;}
__device__ __forceinline__ float max2f(float a,float b){float r;asm("v_max_f32_e32 %0, %1, %2":"=v"(r):"v"(a),"v"(b));return r;}
__device__ __forceinline__ float fadd_s(float a,float b){float r;asm("v_add_f32_e32 %0, %1, %2":"=v"(r):"v"(a),"v"(b));return r;}
__device__ __forceinline__ float fsub_s(float a,float b){float r;asm("v_sub_f32_e32 %0, %1, %2":"=v"(r):"v"(a),"v"(b));return r;}
typedef float f32x2_t __attribute__((ext_vector_type(2))); typedef __bf16 bf16x2_t __attribute__((ext_vector_type(2)));
__device__ __forceinline__ unsigned cvtpk_s(float lo,float hi){f32x2_t v={lo,hi};bf16x2_t b=__builtin_convertvector(v,bf16x2_t);return __builtin_bit_cast(unsigned,b);}
#define WAIT_BAR(N) asm volatile("s_waitcnt vmcnt(" #N ") lgkmcnt(0)\n\ts_barrier":::"memory")

__device__ __forceinline__ void qkt(f32x16&p0,f32x16&p1,const char*Kslot,const bf16x8*qr,const f32x16&negm,int r32,int hi){
  const char*kb=Kslot+hi*1024+r32*16;
  #pragma unroll
  for(int d0=0;d0<4;++d0){
    const bf16x8 b0=*reinterpret_cast<const bf16x8*>(kb+d0*2048);
    const bf16x8 b1=*reinterpret_cast<const bf16x8*>(kb+d0*2048+512);
    if(d0==0){p0=__builtin_amdgcn_mfma_f32_32x32x16_bf16(b0,qr[0],negm,0,0,0);p1=__builtin_amdgcn_mfma_f32_32x32x16_bf16(b1,qr[0],negm,0,0,0);}
    else{p0=__builtin_amdgcn_mfma_f32_32x32x16_bf16(b0,qr[d0],p0,0,0,0);p1=__builtin_amdgcn_mfma_f32_32x32x16_bf16(b1,qr[d0],p1,0,0,0);}}
}
typedef __attribute__((address_space(3))) const char* lds_cptr;
typedef short v4i16_t __attribute__((ext_vector_type(4)));
__device__ __forceinline__ void kload8(bf16x8*kf,lds_cptr kp){
  kf[0]=*(const __attribute__((address_space(3))) bf16x8*)(kp);      kf[1]=*(const __attribute__((address_space(3))) bf16x8*)(kp+512);
  kf[2]=*(const __attribute__((address_space(3))) bf16x8*)(kp+2048); kf[3]=*(const __attribute__((address_space(3))) bf16x8*)(kp+2560);
  kf[4]=*(const __attribute__((address_space(3))) bf16x8*)(kp+4096); kf[5]=*(const __attribute__((address_space(3))) bf16x8*)(kp+4608);
  kf[6]=*(const __attribute__((address_space(3))) bf16x8*)(kp+6144); kf[7]=*(const __attribute__((address_space(3))) bf16x8*)(kp+6656);
}
__device__ __forceinline__ void kload2(bf16x8*kf,lds_cptr kp,int j){ kf[2*j]=*(const __attribute__((address_space(3))) bf16x8*)(kp+j*2048); kf[2*j+1]=*(const __attribute__((address_space(3))) bf16x8*)(kp+j*2048+512); }
__device__ __forceinline__ s16x4 vtr(lds_cptr p){ return __builtin_bit_cast(s16x4,__builtin_amdgcn_ds_read_tr16_b64_v4i16((__attribute__((address_space(3))) v4i16_t*)p)); }
__device__ __forceinline__ float rowmax(const f32x16&p0,const f32x16&p1){
  float a=max3f(p0[0],p0[1],p1[0]),b=max3f(p0[2],p0[3],p1[1]);a=max3f(a,p1[2],p1[3]);
  #pragma unroll
  for(int r=4;r<16;r+=4){a=max3f(a,p0[r],p0[r+1]);b=max3f(b,p0[r+2],p0[r+3]);a=max3f(a,p1[r],p1[r+1]);b=max3f(b,p1[r+2],p1[r+3]);}
  const float m=max2f(a,b);
  auto rr=__builtin_amdgcn_permlane32_swap(__float_as_uint(m),__float_as_uint(m),false,false);
  return max2f(__uint_as_float(rr[0]),__uint_as_float(rr[1]));
}
__device__ __forceinline__ void pv(f32x16*o,int vb,bf16x8 pa0,bf16x8 pa1,bf16x8 pa2,bf16x8 pa3){
  #pragma unroll
  for(int d0=0;d0<2;++d0){s16x4 lo[4],hi[4];
    #pragma unroll
    for(int ks=0;ks<4;++ks){
      asm volatile("ds_read_b64_tr_b16 %0,%1 offset:%c2":"=&v"(lo[ks]):"v"(vb),"i"(d0*4096+ks*1024):"memory");
      asm volatile("ds_read_b64_tr_b16 %0,%1 offset:%c2":"=&v"(hi[ks]):"v"(vb),"i"(d0*4096+ks*1024+512):"memory");}
    asm volatile("s_waitcnt lgkmcnt(0)":::"memory");SBAR();
    #define PK(k) (bf16x8){lo[k][0],lo[k][1],lo[k][2],lo[k][3],hi[k][0],hi[k][1],hi[k][2],hi[k][3]}
    o[d0]=__builtin_amdgcn_mfma_f32_32x32x16_bf16(pa0,PK(0),o[d0],0,0,0);
    o[d0]=__builtin_amdgcn_mfma_f32_32x32x16_bf16(pa1,PK(1),o[d0],0,0,0);
    o[d0]=__builtin_amdgcn_mfma_f32_32x32x16_bf16(pa2,PK(2),o[d0],0,0,0);
    o[d0]=__builtin_amdgcn_mfma_f32_32x32x16_bf16(pa3,PK(3),o[d0],0,0,0);
    #undef PK
  }
}

#ifndef ATTN_STORE16
#define ATTN_STORE16(p,v) (*(u32x4*)(p)=(v))
#endif
template<int THRL> __device__ __forceinline__ void attn_unit(int b,int qb,const bf16*Q,const bf16*__restrict__ K,const bf16*__restrict__ V,bf16*O,char*shm,lds_cfp rt){
  const int tid=threadIdx.x,lane=tid&63,r32=lane&31,hi=lane>>5; const int wid=__builtin_amdgcn_readfirstlane(tid>>6);
  const long rowbase=(long)b*SEQ; const int q0=qb*QB;
  const bf16*Qw=Q+(rowbase+q0+wid*QBLK)*PQ;
  const bf16*Kh=K+rowbase*PQ,*Vh=V+rowbase*PQ;
  const unsigned lds0=(unsigned)(uintptr_t)shm;
  float*wsf=(float*)(shm+LDS_WS)+wid*64;
  const bf16*ksrc=Kh+(long)lane*PQ+wid*8;
  const bf16*vsrc=Vh+(long)(16*(wid&3)+(lane>>2))*PQ+(wid>>2)*32+(lane&3)*8;
  const unsigned kdst=lds0+LDS_K+wid*1024, vdst=lds0+LDS_V+wid*1024;
  #define DMA_K(t,slot) glds16(ksrc+(long)(t)*KVBLK*PQ,(unsigned)__builtin_amdgcn_readfirstlane(kdst+(slot)))
  #define DMA_V(t,slot) glds16(vsrc+(long)(t)*KVBLK*PQ,(unsigned)__builtin_amdgcn_readfirstlane(vdst+(slot)))
  const int vb0=(int)(lds0+LDS_V)+((lane>>4)&1)*32+(lane&3)*8+(4*hi+((lane&15)>>2))*64;
  const char*Kbase=shm+LDS_K; bf16x8 kf[8];
  const lds_cptr shm3=(lds_cptr)shm; const lds_cptr kp0=shm3+LDS_K+hi*1024+r32*16; const lds_cptr vp0=shm3+LDS_V+((lane>>4)&1)*32+(lane&3)*8+(4*hi+((lane&15)>>2))*64;
  const int NT=(q0+QB)/KVBLK;
  DMA_K(0,0);DMA_V(0,0);DMA_K(1,SLOTB);
  bf16x8 qr[4];
  #pragma unroll
  for(int d0=0;d0<4;++d0)qr[d0]=*reinterpret_cast<const bf16x8*>(&Qw[(long)r32*PQ+d0*16+hi*8]);
  float mhat=0.f,l_reg=0.f;f32x16 o[2];o[0]=f32x16{};o[1]=f32x16{};f32x16 negm=f32x16{};asm volatile("":"+v"(negm));
  const int qrel=wid*QBLK+r32;
  #define CMASK(P0,P1,t) do{int jb_=(t)-(NT-4); if(jb_>=-2)biasmask(P0,P1,jb_,qrel,hi,rt);}while(0)
  bool resc=false;
  #define START(P0,P1) do{ const float rm=rowmax(P0,P1); resc=false; \
    { const float dl=rm; mhat=fadd_s(mhat,dl); \
      _Pragma("unroll") for(int r=0;r<16;++r){P0[r]=fsub_s(P0[r],dl);P1[r]=fsub_s(P1[r],dl);} \
      _Pragma("unroll") for(int r=0;r<16;++r)negm[r]=-mhat; asm volatile("":"+v"(negm)); } \
    _Pragma("unroll") for(int r=0;r<16;++r)P0[r]=__builtin_amdgcn_exp2f(P0[r]); }while(0)
  #define RESC() do{ if(resc){ asm volatile("s_waitcnt lgkmcnt(0)":::"memory"); \
      _Pragma("unroll") for(int d_=0;d_<2;++d_) _Pragma("unroll") for(int r=0;r<16;++r)o[d_][r]*=wsf[crow(r,hi)]; } }while(0)
  f32x16 pA0,pA1,pB0,pB1;
  int sl_prev=0,sl_cur=0,sl_next=SLOTB;
  #define ROT() do{sl_prev=sl_cur;sl_cur=sl_next;sl_next=(sl_next==(NSLOT-1)*SLOTB)?0:sl_next+SLOTB;}while(0)
  DMA_K(2,2*SLOTB);
  WAIT_BAR(3);
  qkt(pA0,pA1,Kbase,qr,negm,r32,hi);asm volatile("s_nop 15\n\ts_nop 7":"+v"(pA0),"+v"(pA1));CMASK(pA0,pA1,0);
  START(pA0,pA1);
  _Pragma("unroll") for(int r=0;r<16;++r)pA1[r]=__builtin_amdgcn_exp2f(pA1[r]);
  WAIT_BAR(0);
  DMA_K(3,0);DMA_V(1,SLOTB);
  ROT();
  kload8(kf,kp0+sl_cur);
  WAIT_BAR(2);
  s16x4 vlo[8],vhi[8]; u32x4 pw0,pw1,pw2,pw3;
  #define PKW(P,B) cvtpk_s(P[B],P[B+1])
  #define PAF(k) __builtin_bit_cast(bf16x8,pw##k)
  #define VFR(i) (bf16x8){vlo[i][0],vlo[i][1],vlo[i][2],vlo[i][3],vhi[i][0],vhi[i][1],vhi[i][2],vhi[i][3]}
  #define PIN(x) asm volatile("":"+v"(x))
  #define MX3(a,b,c) __builtin_fmaxf(__builtin_fmaxf((a),(b)),(c))
  #define GAPA(MF,A0,A1,A2,A3,W0,W1,PW) do{ MF; sacc+=A0; sacc+=A1; sacc+=A2; sacc+=A3; PIN(sacc); W0; W1; PIN(PW); SBAR(); }while(0)
  #define EX(v) __builtin_amdgcn_exp2f(v)
  #define GAPB(MF,X,B) do{ MF; X[B]=EX(X[B]); X[B+1]=EX(X[B+1]); X[B+2]=EX(X[B+2]); X[B+3]=EX(X[B+3]); PIN(X); SBAR(); }while(0)
  #define VRD(i) do{ vlo[i]=vtr(vp_+(((i)>>2)*4096+((i)&3)*1024)); vhi[i]=vtr(vp_+(((i)>>2)*4096+((i)&3)*1024+512)); }while(0)
  #define KRD(G,j) do{ if(G){ kload2(kf,kp0+sl_next,j); SBAR(); } }while(0)
  #define STEP(C0,C1,P0,P1,t,GK,GV,GL) do{ SBAR(); \
    const lds_cptr vp_=vp0+sl_prev; \
    VRD(0); SBAR(); float sacc=(P0[0]+P0[1]); \
    GAPA(C0=__builtin_amdgcn_mfma_f32_32x32x16_bf16(kf[0],qr[0],negm,0,0,0), P0[2],P0[3],P0[4],P0[5],     pw0[0]=PKW(P0,0), pw0[1]=PKW(P0,2), pw0); \
    VRD(4); SBAR(); GAPA(C1=__builtin_amdgcn_mfma_f32_32x32x16_bf16(kf[1],qr[0],negm,0,0,0), P0[6],P0[7],P0[8],P0[9],     pw0[2]=PKW(P0,4), pw0[3]=PKW(P0,6), pw0); \
    VRD(1); SBAR(); GAPA(C0=__builtin_amdgcn_mfma_f32_32x32x16_bf16(kf[2],qr[1],C0,0,0,0),   P0[10],P0[11],P0[12],P0[13], pw1[0]=PKW(P0,8), pw1[1]=PKW(P0,10), pw1); \
    VRD(5); SBAR(); GAPA(C1=__builtin_amdgcn_mfma_f32_32x32x16_bf16(kf[3],qr[1],C1,0,0,0),   P0[14],P0[15],P1[0],P1[1],   pw1[2]=PKW(P0,12),pw1[3]=PKW(P0,14), pw1); \
    VRD(2); SBAR(); GAPA(C0=__builtin_amdgcn_mfma_f32_32x32x16_bf16(kf[4],qr[2],C0,0,0,0),   P1[2],P1[3],P1[4],P1[5],     pw2[0]=PKW(P1,0), pw2[1]=PKW(P1,2), pw2); \
    VRD(6); SBAR(); GAPA(C1=__builtin_amdgcn_mfma_f32_32x32x16_bf16(kf[5],qr[2],C1,0,0,0),   P1[6],P1[7],P1[8],P1[9],     pw2[2]=PKW(P1,4), pw2[3]=PKW(P1,6), pw2); \
    VRD(3); SBAR(); GAPA(C0=__builtin_amdgcn_mfma_f32_32x32x16_bf16(kf[6],qr[3],C0,0,0,0),   P1[10],P1[11],P1[12],P1[13], pw3[0]=PKW(P1,8), pw3[1]=PKW(P1,10), pw3); \
    VRD(7); SBAR(); GAPA(C1=__builtin_amdgcn_mfma_f32_32x32x16_bf16(kf[7],qr[3],C1,0,0,0),   P1[14],P1[15],0.f,0.f,       pw3[2]=PKW(P1,12),pw3[3]=PKW(P1,14), pw3); \
    l_reg+=sacc; \
    if(GK){DMA_K((t)+3,sl_cur);} if(GV){DMA_V((t)+1,sl_next);} \
    CMASK(C0,C1,t); \
    { float a=MX3(C0[0],C0[1],C1[0]),b=MX3(C0[2],C0[3],C1[1]); a=MX3(a,C1[2],C1[3]); \
      _Pragma("unroll") for(int r=4;r<16;r+=4){a=MX3(a,C0[r],C0[r+1]);b=MX3(b,C0[r+2],C0[r+3]);a=MX3(a,C1[r],C1[r+1]);b=MX3(b,C1[r+2],C1[r+3]);} \
      float rm=__builtin_fmaxf(a,b); { auto rr=__builtin_amdgcn_permlane32_swap(__float_as_uint(rm),__float_as_uint(rm),false,false); rm=__builtin_fmaxf(__uint_as_float(rr[0]),__uint_as_float(rr[1])); } \
      resc=false; \
      if(__builtin_expect(__any(rm>(float)THRL),0)){ const float dl=__builtin_fmaxf(rm,0.f); mhat+=dl; \
        _Pragma("unroll") for(int r=0;r<16;++r){C0[r]-=dl;C1[r]-=dl;} \
        _Pragma("unroll") for(int r=0;r<16;++r)negm[r]=-mhat; asm volatile("":"+v"(negm)); \
        const float f=__builtin_amdgcn_exp2f(-dl); l_reg*=f; if(hi==0)wsf[r32]=f; resc=true; } } \
    SBAR(); \
    GAPB(o[0]=__builtin_amdgcn_mfma_f32_32x32x16_bf16(PAF(0),VFR(0),o[0],0,0,0), C0,0); \
    GAPB(o[1]=__builtin_amdgcn_mfma_f32_32x32x16_bf16(PAF(0),VFR(4),o[1],0,0,0), C0,4); \
    KRD(GL,0); GAPB(o[0]=__builtin_amdgcn_mfma_f32_32x32x16_bf16(PAF(1),VFR(1),o[0],0,0,0), C0,8); \
    KRD(GL,1); GAPB(o[1]=__builtin_amdgcn_mfma_f32_32x32x16_bf16(PAF(1),VFR(5),o[1],0,0,0), C0,12); \
    KRD(GL,2); GAPB(o[0]=__builtin_amdgcn_mfma_f32_32x32x16_bf16(PAF(2),VFR(2),o[0],0,0,0), C1,0); \
    KRD(GL,3); GAPB(o[1]=__builtin_amdgcn_mfma_f32_32x32x16_bf16(PAF(2),VFR(6),o[1],0,0,0), C1,4); \
    GAPB(o[0]=__builtin_amdgcn_mfma_f32_32x32x16_bf16(PAF(3),VFR(3),o[0],0,0,0), C1,8); \
    GAPB(o[1]=__builtin_amdgcn_mfma_f32_32x32x16_bf16(PAF(3),VFR(7),o[1],0,0,0), C1,12); \
    }while(0)
  int t=1;
  #undef CMASK
  #define CMASK(P0,P1,t) do{}while(0)
  for(;t+7<NT;t+=2){
    STEP(pB0,pB1,pA0,pA1,t,true,true,true);     WAIT_BAR(2); RESC(); ROT();
    STEP(pA0,pA1,pB0,pB1,t+1,true,true,true);   WAIT_BAR(2); RESC(); ROT();
  }
  #undef CMASK
  #define CMASK(P0,P1,t) do{int jb_=(t)-(NT-4); if(jb_>=-2)biasmask(P0,P1,jb_,qrel,hi,rt);}while(0)
  #define ENDW(tt) do{ if((tt)+3<NT){WAIT_BAR(2);} else if((tt)+2<NT){WAIT_BAR(1);} else {WAIT_BAR(0);} }while(0)
  for(;t+1<NT;t+=2){
    STEP(pB0,pB1,pA0,pA1,t,(t+3<NT),(t+1<NT),(t+1<NT));       ENDW(t);   RESC(); ROT();
    STEP(pA0,pA1,pB0,pB1,t+1,(t+4<NT),(t+2<NT),(t+2<NT));     ENDW(t+1); RESC(); ROT();
  }
  STEP(pB0,pB1,pA0,pA1,NT-1,false,false,false); RESC();
  { float sacc=pB0[0]+pB0[1]; _Pragma("unroll") for(int r=2;r<16;++r)sacc+=pB0[r]; _Pragma("unroll") for(int r=0;r<16;++r)sacc+=pB1[r]; l_reg+=sacc;
    pw0=(u32x4){PKW(pB0,0),PKW(pB0,2),PKW(pB0,4),PKW(pB0,6)};pw1=(u32x4){PKW(pB0,8),PKW(pB0,10),PKW(pB0,12),PKW(pB0,14)};pw2=(u32x4){PKW(pB1,0),PKW(pB1,2),PKW(pB1,4),PKW(pB1,6)};pw3=(u32x4){PKW(pB1,8),PKW(pB1,10),PKW(pB1,12),PKW(pB1,14)};
    SBAR(); pv(o,vb0+sl_cur,PAF(0),PAF(1),PAF(2),PAF(3)); }
  #undef PKW
  #undef PAF
  #undef VFR
  #undef PIN
  #undef MX3
  #undef GAPA
  #undef GAPB
  #undef EX
  #undef VRD
  #undef KRD
  #undef STEP
  #undef ENDW
  {auto rr=__builtin_amdgcn_permlane32_swap(__float_as_uint(l_reg),__float_as_uint(l_reg),false,false);l_reg=__uint_as_float(rr[0])+__uint_as_float(rr[1]);}
  if(hi==0)wsf[32+r32]=l_reg;asm volatile("s_waitcnt lgkmcnt(0)":::"memory");
  float rli[16];
  #pragma unroll
  for(int r=0;r<16;++r)rli[r]=__builtin_amdgcn_rcpf(wsf[32+crow(r,hi)]);
  bf16*Ow=O+(rowbase+q0+wid*QBLK)*PO;
  { bf16*stg=(bf16*)(shm+LDS_OST)+wid*2048;
    #pragma unroll
    for(int r=0;r<16;++r){const int orow=crow(r,hi);
      #pragma unroll
      for(int d0=0;d0<2;++d0)stg[orow*64+d0*32+r32]=(bf16)(cvtpk_s(o[d0][r]*rli[r],0.f)&0xffffu);}
    asm volatile("s_waitcnt lgkmcnt(0)":::"memory");
    #pragma unroll
    for(int i=0;i<4;++i){const int row=i*8+(lane>>3),ch=lane&7; const u32x4 v=*(const u32x4*)(stg+row*64+ch*8); ATTN_STORE16(Ow+(long)row*PO+ch*8,v);} }
  asm volatile("s_waitcnt lgkmcnt(0)\n\ts_barrier":::"memory");
  #undef DMA_K
  #undef DMA_V
  #undef CMASK
  #undef START
  #undef RESC
  #undef ROT
}
constexpr int ATTN_LDS_BYTES=LDS_BYTES;
#undef SBAR
#undef WAIT_BAR
}
struct Args { const float* in[31]; float* out; unsigned char* ws; int ph_lo, ph_hi; };
struct Frame {
    LAS unsigned char* lds; volatile LAS unsigned* MISC; gu32* ctl;
    int tid, lane, wave, vcu, G;
};
typedef float f32x2 __attribute__((ext_vector_type(2)));
__device__ __forceinline__ float wave_sum(float v) {
#pragma unroll
    for (int o = 1; o < 64; o <<= 1) v += __shfl_xor(v, o);
    return v;
}
using pg8::bf_lo; using pg8::bf_hi;

__device__ __forceinline__ void p0_transpose_item(const float* W, int ldw, bf16* WT, int Kd, int drow, int k0, int n0, LAS float* scr, int lane) {
#pragma unroll 8
    for (int i = 0; i < 32; ++i) { const int kk = 2 * i + (lane >> 5); scr[kk * 33 + (lane & 31)] = W[(size_t)(k0 + kk) * ldw + n0 + (lane & 31)]; }
    LDS_WAIT(); asm volatile("" ::: "memory");
    const int c = lane & 7;
#pragma unroll
    for (int j = 0; j < 4; ++j) { const int n = (lane >> 3) + 8 * j; const LAS float* s = scr + (8 * c) * 33 + n;
        v4u o; o.x = pk2(s[0 * 33], s[1 * 33]); o.y = pk2(s[2 * 33], s[3 * 33]); o.z = pk2(s[4 * 33], s[5 * 33]); o.w = pk2(s[6 * 33], s[7 * 33]);
        *(GAS v4u*)(WT + (size_t)(drow + n) * Kd + k0 + 8 * c) = o; }
    LDS_WAIT(); asm volatile("" ::: "memory");
}
__device__ __forceinline__ void ln_row(const float* xrow, const float* g, const float* b, float* of32, bf16* obf, float* stat, int lane) {
    const f32x4* xr = (const f32x4*)xrow + lane;
    f32x4 v[4]; float s = 0.f;
#pragma unroll
    for (int j = 0; j < 4; ++j) { v[j] = xr[64 * j]; s += (v[j].x + v[j].y) + (v[j].z + v[j].w); }
    const float mean = wave_sum(s) * (1.f / DM); float s2 = 0.f;
#pragma unroll
    for (int j = 0; j < 4; ++j) { v[j] = v[j] - mean; s2 += (v[j].x * v[j].x + v[j].y * v[j].y) + (v[j].z * v[j].z + v[j].w * v[j].w); }
    const float rstd = 1.f / sqrtf(wave_sum(s2) * (1.f / DM) + LN_EPS);
    if (stat && lane == 0) { stat[0] = mean; stat[1] = rstd; }
#pragma unroll
    for (int j = 0; j < 4; ++j) { const f32x4 gg = ((const f32x4*)g)[lane + 64 * j], bb = ((const f32x4*)b)[lane + 64 * j]; const f32x4 y = v[j] * rstd * gg + bb;
        if (of32) ((f32x4*)of32)[lane + 64 * j] = y;
        if (obf) ((unsigned long long*)obf)[lane + 64 * j] = (unsigned long long)pk2(y.x, y.y) | ((unsigned long long)pk2(y.z, y.w) << 32); }
}
__device__ __forceinline__ void p0_prologue(Frame& F, const Args& a) {
    unsigned char* ws = a.ws;
    LAS float* scr = (LAS float*)(F.lds + RING_OFF + F.wave * 16384);
    const int gw = F.vcu * NWAVES + F.wave, NGW = F.G * NWAVES;
    constexpr int I_IN = 16 * 168, I_UP = 8 * 32, I_OUT = 16 * 32, I_G = 16 * 88, I_DN = 44 * 32;
    constexpr int NITEMS = I_IN + 2 * I_UP + I_OUT + 2 * I_G + I_DN;
    for (int it = gw; it < NITEMS; it += NGW) {
        int r = it;
        if (r < I_IN) { const int kb = r / 168, nb = r % 168; p0_transpose_item(a.in[4], NPROJ, (bf16*)(ws + WS_WIN), 1024, 32 * nb, 64 * kb, 32 * nb, scr, F.lane); continue; } r -= I_IN;
        if (r < I_UP) { const int kb = r / 32, nb = r % 32; p0_transpose_item(a.in[21], 1024, (bf16*)(ws + WS_WUPA), 512, 32 * nb, 64 * kb, 32 * nb, scr, F.lane); continue; } r -= I_UP;
        if (r < I_UP) { const int kb = r / 32, nb = r % 32; p0_transpose_item(a.in[22], 1024, (bf16*)(ws + WS_WUPB), 512, 32 * nb, 64 * kb, 32 * nb, scr, F.lane); continue; } r -= I_UP;
        if (r < I_OUT) { const int kb = r / 32, nb = r % 32; p0_transpose_item(a.in[23], 1024, (bf16*)(ws + WS_WOUT), 1024, 32 * nb, 64 * kb, 32 * nb, scr, F.lane); continue; } r -= I_OUT;
        if (r < I_G) { const int kb = r / 88, nb = r % 88, n0 = 32 * nb; p0_transpose_item(a.in[26], FFH, (bf16*)(ws + WS_WGU), 1024, 256 * (n0 >> 7) + (n0 & 127), 64 * kb, n0, scr, F.lane); continue; } r -= I_G;
        if (r < I_G) { const int kb = r / 88, nb = r % 88, n0 = 32 * nb; p0_transpose_item(a.in[27], FFH, (bf16*)(ws + WS_WGU), 1024, 256 * (n0 >> 7) + 128 + (n0 & 127), 64 * kb, n0, scr, F.lane); continue; } r -= I_G;
        { const int kb = r / 32, nb = r % 32; p0_transpose_item(a.in[28], 1024, (bf16*)(ws + WS_WDN), FFH, 32 * nb, 64 * kb, 32 * nb, scr, F.lane); }
    }
    { bf16* B2 = (bf16*)(ws + WS_B2); const float* w2 = a.in[12]; const float* a2 = a.in[14]; const float* g2 = a.in[15];
      for (int e = (F.vcu * 512 + F.tid); e < 1536 * 256; e += F.G * 512) { const int n = e >> 8, k = e & 255; float v = 0.f;
          if (n < 512) { if (k < 64) v = w2[k * 512 + n]; }
          else if (n < 1024) { if (k >= 64 && k < 128) v = a2[(k - 64) * 512 + (n - 512)]; }
          else { if (k >= 128) v = g2[(k - 128) * 512 + (n - 1024)]; }
          B2[e] = (bf16)(pk2(v, 0.f) & 0xffffu); } }
    for (int m = gw; m < MTOK; m += NGW) ln_row(a.in[0] + (size_t)m * DM, a.in[1], a.in[2], nullptr, (bf16*)(ws + WS_HN) + (size_t)m * DM, (float*)(ws + WS_STATS) + 2 * m, F.lane);
}
__device__ __forceinline__ void p2a_shift(Frame& F, const Args& a) {
    unsigned char* ws = a.ws;
    const bf16* RW = (const bf16*)(ws + WS_RW); const float* mu = a.in[10]; const float* k_k = a.in[16];
    bf16* RR = (bf16*)(ws + WS_RR); bf16* KK = (bf16*)(ws + WS_KK); bf16* VV = (bf16*)(ws + WS_VV); bf16* A2 = (bf16*)(ws + WS_A2); float* INV = (float*)(ws + WS_INVN);
    const int gw = F.vcu * NWAVES + F.wave, NGW = F.G * NWAVES, lane = F.lane;
    for (int m = gw; m < MTOK; m += NGW) {
        const bool first = (m & (SEQ - 1)) == 0;
#pragma unroll
        for (int it = 0; it < 4; ++it) {
            const int c0 = lane * 8 + it * 512;
            if (it < 3 || lane < 32) {
                const v4u cur = *(const v4u*)(RW + (size_t)m * 1792 + c0);
                v4u prv = (v4u){0u, 0u, 0u, 0u}; if (!first) prv = *(const v4u*)(RW + (size_t)(m - 1) * 1792 + c0);
                const f32x4 m0 = *(const f32x4*)(mu + c0), m1 = *(const f32x4*)(mu + c0 + 4);
                float xs[8];
                { const unsigned cw[4] = {cur.x, cur.y, cur.z, cur.w}, pw[4] = {prv.x, prv.y, prv.z, prv.w}; const float mm[8] = {m0.x, m0.y, m0.z, m0.w, m1.x, m1.y, m1.z, m1.w};
#pragma unroll
                  for (int e = 0; e < 4; ++e) { const float c_lo = bf_lo(cw[e]), c_hi = bf_hi(cw[e]), p_lo = bf_lo(pw[e]), p_hi = bf_hi(pw[e]);
                      xs[2 * e] = c_lo + (p_lo - c_lo) * mm[2 * e]; xs[2 * e + 1] = c_hi + (p_hi - c_hi) * mm[2 * e + 1]; } }
                if (it == 3) {
                    const int cl = lane * 8;
#pragma unroll
                    for (int e = 0; e < 8; ++e) { if (cl < 64) xs[e] = tanhf(xs[e]); else if (cl >= 128) xs[e] = 1.0f / (1.0f + expf(-xs[e])); }
                    v4u o; o.x = pk2(xs[0], xs[1]); o.y = pk2(xs[2], xs[3]); o.z = pk2(xs[4], xs[5]); o.w = pk2(xs[6], xs[7]);
                    *(v4u*)(A2 + (size_t)m * 256 + cl) = o;
                } else {
                    v4u o; o.x = pk2(xs[0], xs[1]); o.y = pk2(xs[2], xs[3]); o.z = pk2(xs[4], xs[5]); o.w = pk2(xs[6], xs[7]);
                    const int cc = lane * 8;
                    bf16* dst = (it == 0) ? RR : (it == 1) ? KK : VV;
                    *(v4u*)(dst + (size_t)m * 512 + cc) = o;
                    if (it == 1) {
                        const f32x4 k0 = *(const f32x4*)(k_k + cc), k1 = *(const f32x4*)(k_k + cc + 4);
                        const float kq[8] = {k0.x, k0.y, k0.z, k0.w, k1.x, k1.y, k1.z, k1.w}; const unsigned ow[4] = {o.x, o.y, o.z, o.w};
                        float ss = 0.f;
#pragma unroll
                        for (int e = 0; e < 4; ++e) { const float a0 = bf_lo(ow[e]) * kq[2 * e], a1 = bf_hi(ow[e]) * kq[2 * e + 1]; ss += a0 * a0 + a1 * a1; }
                        ss += __shfl_xor(ss, 1); ss += __shfl_xor(ss, 2); ss += __shfl_xor(ss, 4);
                        if ((lane & 7) == 0) INV[(size_t)m * 8 + (lane >> 3)] = 1.0f / sqrtf(fmaxf(ss, 1e-24f));
                    }
                }
            }
        }
    }
}
__device__ __forceinline__ int t5_bucket(int d) {
    if (d < 16) return d;
    int b = 16;
    b += (d >= 19); b += (d >= 21); b += (d >= 24); b += (d >= 27); b += (d >= 31); b += (d >= 35); b += (d >= 40); b += (d >= 46);
    b += (d >= 52); b += (d >= 59); b += (d >= 67); b += (d >= 77); b += (d >= 87); b += (d >= 99); b += (d >= 113);
    return b;
}
__device__ __forceinline__ float diff_lambda(const Args& a) {
    float s1 = 0.f, s2 = 0.f;
    for (int i = 0; i < 64; ++i) { s1 += a.in[5][i] * a.in[6][i]; s2 += a.in[7][i] * a.in[8][i]; }
    return expf(s1) - expf(s2) + 0.2f;
}
template <int CTRL> __device__ __forceinline__ float dpp_f(float x) { return __builtin_bit_cast(float, __builtin_amdgcn_update_dpp(0, __builtin_bit_cast(int, x), CTRL, 0xF, 0xF, false)); }
__device__ __forceinline__ float red16(float x) { x += dpp_f<0xB1>(x); x += dpp_f<0x4E>(x); x += dpp_f<0x141>(x); x += dpp_f<0x140>(x); return x; }

constexpr int ATT_RT_OFF = 86016;
constexpr int ATT_ITEM_OFF = 86016 + 4 * 640 * 4;
constexpr int CW_ATTQ = 2048;
__device__ __forceinline__ void attn_worker(Frame& F, const Args& a, char* lds_generic) {
    unsigned char* ws = a.ws;
    const bf16* Q = (const bf16*)(ws + WS_Q); const bf16* K = Q + (size_t)MTOK * 512; const bf16* V = K + (size_t)MTOK * 512; bf16* O = (bf16*)(ws + WS_O);
    bf16* YA = (bf16*)(ws + WS_YA); const float* sg = a.in[9];
    LAS float* rt = (LAS float*)(F.lds + RING_OFF + ATT_RT_OFF);
    volatile LAS int* itemw = (volatile LAS int*)(F.lds + RING_OFF + ATT_ITEM_OFF);
    __syncthreads();
    { int tl = F.tid; asm volatile("" : "+v"(tl));
      for (int i = tl; i < 4 * 640; i += NWAVES * 64) { const int h = i / 640, dist = (i - h * 640) - 256; float val = 0.f;
          if (dist < 0) val = -INFINITY; else if (dist < 128) val = (a.in[3][t5_bucket(dist) * 4 + h] - a.in[3][31 * 4 + h]) * LOG2E;
          rt[i] = val; } }
    const float lam = diff_lambda(a);
    for (;;) {
        if (F.tid == 0) *itemw = (int)__hip_atomic_fetch_add(F.ctl + CW_ATTQ, 1u, __ATOMIC_RELAXED, __HIP_MEMORY_SCOPE_AGENT);
        __syncthreads();
        const int item = __builtin_amdgcn_readfirstlane(*itemw);
        if (item >= 512) break;
        const int qb = 7 - (item >> 6), bh = item & 63, b = bh >> 2, h = bh & 3;
        for (int cv = 0; cv < 4; ++cv) { const int c = cv >> 1, vh = cv & 1, hc = h * 2 + c;
            attn_body::attn_unit<0>(b, qb, Q + hc * 64, K + hc * 64, V + h * 128 + vh * 64, O + hc * 128 + vh * 64, lds_generic + RING_OFF, (attn_body::lds_cfp)(rt + h * 640)); }
        asm volatile("s_waitcnt vmcnt(0)" ::: "memory"); __syncthreads();
        { int ln = F.lane; asm volatile("" : "+v"(ln));
          const int e0 = (ln & 15) * 8; const f32x4 g0 = *(const f32x4*)(sg + e0), g1 = *(const f32x4*)(sg + e0 + 4);
#pragma unroll 2
          for (int it = 0; it < 8; ++it) { const size_t m = (size_t)b * SEQ + qb * 256 + F.wave * 32 + it * 4 + (ln >> 4);
            const v4u w0 = *(const v4u*)(O + m * 1024 + (h * 2) * 128 + e0), w1 = *(const v4u*)(O + m * 1024 + (h * 2 + 1) * 128 + e0);
            float d[8] = { bf_lo(w0.x) - lam * bf_lo(w1.x), bf_hi(w0.x) - lam * bf_hi(w1.x), bf_lo(w0.y) - lam * bf_lo(w1.y), bf_hi(w0.y) - lam * bf_hi(w1.y),
                           bf_lo(w0.z) - lam * bf_lo(w1.z), bf_hi(w0.z) - lam * bf_hi(w1.z), bf_lo(w0.w) - lam * bf_lo(w1.w), bf_hi(w0.w) - lam * bf_hi(w1.w) };
            float ss = 0.f;
#pragma unroll
            for (int e = 0; e < 8; ++e) ss += d[e] * d[e];
            ss = red16(ss);
            const float r = 0.8f / sqrtf(ss * (1.0f / 128.0f) + LN_EPS);
            v4u o; o.x = pk2(d[0] * r * g0.x, d[1] * r * g0.y); o.y = pk2(d[2] * r * g0.z, d[3] * r * g0.w); o.z = pk2(d[4] * r * g1.x, d[5] * r * g1.y); o.w = pk2(d[6] * r * g1.z, d[7] * r * g1.w);
            *(v4u*)(YA + m * 512 + h * 128 + e0) = o; } }
        __syncthreads();
    }
}
constexpr int SC_TC = 32, SC_BUF = 6 * SC_TC * 64;
__device__ __forceinline__ void scan_unit(Frame& F, const Args& a, int bh) {
    unsigned char* ws = a.ws;
    const bf16* RR = (const bf16*)(ws + WS_RR); const bf16* KK = (const bf16*)(ws + WS_KK); const bf16* VV = (const bf16*)(ws + WS_VV);
    const float* DEC = (const float*)(ws + WS_DEC); const bf16* AA = (const bf16*)(ws + WS_AA); const bf16* GG = (const bf16*)(ws + WS_GG); const float* INV = (const float*)(ws + WS_INVN);
    bf16* YB = (bf16*)(ws + WS_YB);
    const float* k_k = a.in[16]; const float* k_a = a.in[17]; const float* r_k = a.in[18]; const float* lnx_g = a.in[19]; const float* lnx_b = a.in[20];
    LAS float* L = (LAS float*)(F.lds + RING_OFF);
    LAS float* Ly = L + 2 * SC_BUF;
    const int tid = F.tid, rp = tid >> 4, jg = tid & 15;
    const int b = bh >> 3, h = bh & 7;
    const int ptt = tid >> 4, pj0 = (tid & 15) * 4, pcol = h * 64 + pj0;
    const f32x4 kk4 = *(const f32x4*)(k_k + pcol), ka4 = *(const f32x4*)(k_a + pcol), rk4 = *(const f32x4*)(r_k + pcol), lg4 = *(const f32x4*)(lnx_g + pcol), lb4 = *(const f32x4*)(lnx_b + pcol);
    typedef pg8::u32x2 u2;
    u2 pr, pk, pv, pa, pg, pgn; f32x4 pd; float pinv;
#define SC_LOAD(c0_) do { const size_t m_ = (size_t)b * SEQ + (c0_) + ptt; const size_t off_ = m_ * 512 + pcol; \
        pr = *(const u2*)(RR + off_); pk = *(const u2*)(KK + off_); pv = *(const u2*)(VV + off_); pa = *(const u2*)(AA + off_); pgn = *(const u2*)(GG + off_); pd = *(const f32x4*)(DEC + off_); pinv = INV[m_ * 8 + h]; } while (0)
#define SC_STORE(buf_) do { LAS float* B_ = L + (buf_) * SC_BUF + ptt * 64 + pj0; \
        const f32x4 kv_ = (f32x4){bf_lo(pk.x), bf_hi(pk.x), bf_lo(pk.y), bf_hi(pk.y)}, av_ = (f32x4){bf_lo(pa.x), bf_hi(pa.x), bf_lo(pa.y), bf_hi(pa.y)}; \
        const f32x4 kkv_ = kv_ * kk4 * pinv; \
        *(LAS f32x4*)(B_) = pd; *(LAS f32x4*)(B_ + SC_TC * 64) = kkv_; *(LAS f32x4*)(B_ + 2 * SC_TC * 64) = kkv_ * av_; *(LAS f32x4*)(B_ + 3 * SC_TC * 64) = kv_ * (1.0f + (av_ - 1.0f) * ka4); \
        *(LAS f32x4*)(B_ + 4 * SC_TC * 64) = (f32x4){bf_lo(pr.x), bf_hi(pr.x), bf_lo(pr.y), bf_hi(pr.y)}; *(LAS f32x4*)(B_ + 5 * SC_TC * 64) = (f32x4){bf_lo(pv.x), bf_hi(pv.x), bf_lo(pv.y), bf_hi(pv.y)}; } while (0)
    __syncthreads();
    SC_LOAD(0); SC_STORE(0); pg = pgn;
    __syncthreads();
    f32x4 S0 = (f32x4){0.f, 0.f, 0.f, 0.f}, S1 = S0;
    for (int c = 0; c < SEQ / SC_TC; ++c) {
        const int cur = c & 1;
        if (c + 1 < SEQ / SC_TC) SC_LOAD((c + 1) * SC_TC);
        const LAS float* B = L + cur * SC_BUF + jg * 4;
#pragma unroll 4
        for (int tt = 0; tt < SC_TC; ++tt) {
            const f32x4 kq = *(const LAS f32x4*)(B + SC_TC * 64 + tt * 64), dq = *(const LAS f32x4*)(B + tt * 64), bq = *(const LAS f32x4*)(B + 2 * SC_TC * 64 + tt * 64),
                        pq = *(const LAS f32x4*)(B + 3 * SC_TC * 64 + tt * 64), rq = *(const LAS f32x4*)(B + 4 * SC_TC * 64 + tt * 64);
            const f32x2 vq = *(const LAS f32x2*)(L + cur * SC_BUF + 5 * SC_TC * 64 + tt * 64 + 2 * rp);
            float sa0 = (S0.x * kq.x + S0.y * kq.y) + (S0.z * kq.z + S0.w * kq.w), sa1 = (S1.x * kq.x + S1.y * kq.y) + (S1.z * kq.z + S1.w * kq.w);
            sa0 = -red16(sa0); sa1 = -red16(sa1);
            S0 = S0 * dq + bq * sa0 + pq * vq.x; S1 = S1 * dq + bq * sa1 + pq * vq.y;
            float y0 = (S0.x * rq.x + S0.y * rq.y) + (S0.z * rq.z + S0.w * rq.w), y1 = (S1.x * rq.x + S1.y * rq.y) + (S1.z * rq.z + S1.w * rq.w);
            y0 = red16(y0); y1 = red16(y1);
            if (jg == 0) *(LAS f32x2*)(Ly + tt * 64 + 2 * rp) = (f32x2){y0, y1};
        }
        __syncthreads();
        { const size_t m = (size_t)b * SEQ + c * SC_TC + ptt;
          const LAS float* Bc = L + cur * SC_BUF + ptt * 64 + pj0;
          const f32x4 y4 = *(const LAS f32x4*)(Ly + ptt * 64 + pj0);
          const float mean = red16((y4.x + y4.y) + (y4.z + y4.w)) * (1.0f / 64.0f); const f32x4 dd = y4 - mean;
          const float rstd = 1.0f / sqrtf(red16((dd.x * dd.x + dd.y * dd.y) + (dd.z * dd.z + dd.w * dd.w)) * (1.0f / 64.0f) + LNX_EPS);
          const f32x4 r4 = *(const LAS f32x4*)(Bc + 4 * SC_TC * 64), kp4 = *(const LAS f32x4*)(Bc + 3 * SC_TC * 64), v4 = *(const LAS f32x4*)(Bc + 5 * SC_TC * 64);
          const float bs = red16((r4.x * kp4.x * rk4.x + r4.y * kp4.y * rk4.y) + (r4.z * kp4.z * rk4.z + r4.w * kp4.w * rk4.w));
          f32x4 ov = dd * rstd * lg4 + lb4 + v4 * bs;
          ov.x *= bf_lo(pg.x); ov.y *= bf_hi(pg.x); ov.z *= bf_lo(pg.y); ov.w *= bf_hi(pg.y);
          u2 w; w.x = pk2(ov.x, ov.y); w.y = pk2(ov.z, ov.w);
          *(u2*)(YB + m * 512 + pcol) = w; }
        if (c + 1 < SEQ / SC_TC) { SC_STORE(cur ^ 1); pg = pgn; }
        __syncthreads();
    }
#undef SC_LOAD
#undef SC_STORE
}
__device__ __forceinline__ void ln_pass(Frame& F, float* Z, const float* g, const float* b, bf16* obf) {
    const int gw = F.vcu * NWAVES + F.wave, NGW = F.G * NWAVES;
    for (int m = gw; m < MTOK; m += NGW) ln_row(Z + (size_t)m * DM, g, b, Z + (size_t)m * DM, obf ? obf + (size_t)m * DM : nullptr, nullptr, F.lane);
}

constexpr int NPHASE = 12;
__global__ void __launch_bounds__(NWAVES * 64, 2) fwd_kernel(Args args) {
    extern __shared__ __attribute__((aligned(16))) unsigned char lds[];
    Frame F;
    F.lds = (LAS unsigned char*)lds;
    F.MISC = (volatile LAS unsigned*)(F.lds + MISC_OFF);
    F.tid = threadIdx.x; F.lane = F.tid & 63; F.wave = __builtin_amdgcn_readfirstlane(F.tid >> 6);
    F.G = gridDim.x; { const int bx = blockIdx.x; F.vcu = (F.G % 8 == 0) ? (bx % 8) * (F.G / 8) + bx / 8 : bx; }
    unsigned char* ws = args.ws;
    F.ctl = (gu32*)(ws + WS_CTL);
    for (int u = F.tid; u < (LDS_BYTES - LDSCTL_OFF) / 4; u += NWAVES * 64) ((LAS unsigned*)(F.lds + LDSCTL_OFF))[u] = 0u;
    __syncthreads();
#if MK_ONE_LAUNCH
    XcdBarrier bar = xcd_barrier_post((unsigned*)(F.ctl + CW_BAR), F.MISC + 8);
#define GRID_BAR() xcd_barrier(bar)
#else
#define GRID_BAR() do {} while (0)
#endif
    const int lo = args.ph_lo, hi = args.ph_hi;
#define IN(k) (lo <= (k) && (k) < hi)
#define BOTH(k) (IN(k) && IN((k) + 1))
    typedef pg8::bf16_t pb;
    if (IN(0)) { p0_prologue(F, args); if (BOTH(0)) GRID_BAR(); }
    if (IN(1)) {
        pg8::Gemm g{(const pb*)(ws + WS_HN), (const pb*)(ws + WS_WIN), MTOK, NPROJ, DM}; pg8::StaticOrder S; S.init(MTOK, NPROJ, F.G, (int)blockIdx.x);
        pg8::EpiProj E{(pb*)(ws + WS_Q), (pb*)(ws + WS_RW), (pb*)args.out};
        pg8::gemm_phase<pg8::EpiProj, pg8::StaticOrder, true, true>(F.lds + RING_OFF, g, S, E);
        if (BOTH(1)) GRID_BAR();
    }
    if (IN(2)) { p2a_shift(F, args); if (BOTH(2)) GRID_BAR(); }
    if (IN(3)) {
        pg8::Gemm g{(const pb*)(ws + WS_A2), (const pb*)(ws + WS_B2), MTOK, 1536, 256}; pg8::StaticOrder S; S.init(MTOK, 1536, F.G, (int)blockIdx.x);
        pg8::EpiLowrank E{(float*)(ws + WS_DEC), (pb*)(ws + WS_AA), (WS_GG - WS_AA) / 2, args.in[11], args.in[13]};
        pg8::gemm_phase<pg8::EpiLowrank, pg8::StaticOrder, true, true>(F.lds + RING_OFF, g, S, E);
        if (BOTH(3)) GRID_BAR();
    }
    if (IN(4)) { for (int bh = F.vcu; bh < NBATCH * 8; bh += F.G) scan_unit(F, args, bh); attn_worker(F, args, (char*)lds); if (BOTH(4)) GRID_BAR(); }
    if (IN(6)) {
        { pg8::Gemm g{(const pb*)(ws + WS_YA), (const pb*)(ws + WS_WUPA), MTOK, DM, 512}; pg8::StaticOrder S; S.init(MTOK, DM, F.G, (int)blockIdx.x);
          pg8::EpiUp<0> E{(const pb*)args.out, (pb*)(ws + WS_T)};
          pg8::gemm_phase<pg8::EpiUp<0>, pg8::StaticOrder, true, true>(F.lds + RING_OFF, g, S, E); }
        asm volatile("s_waitcnt vmcnt(0)" ::: "memory"); __syncthreads();
        { pg8::Gemm g{(const pb*)(ws + WS_YB), (const pb*)(ws + WS_WUPB), MTOK, DM, 512}; pg8::StaticOrder S; S.init(MTOK, DM, F.G, (int)blockIdx.x);
          pg8::EpiUp<1> E{(const pb*)args.out, (pb*)(ws + WS_T)};
          pg8::gemm_phase<pg8::EpiUp<1>, pg8::StaticOrder, true, true>(F.lds + RING_OFF, g, S, E); }
        if (BOTH(6)) GRID_BAR();
    }
    if (IN(7)) {
        pg8::Gemm g{(const pb*)(ws + WS_T), (const pb*)(ws + WS_WOUT), MTOK, DM, DM}; pg8::StaticOrder S; S.init(MTOK, DM, F.G, (int)blockIdx.x);
        pg8::EpiOutZ E{args.in[0], (const float*)(ws + WS_STATS), args.in[1], args.in[2], args.out};
        pg8::gemm_phase<pg8::EpiOutZ, pg8::StaticOrder, true, true>(F.lds + RING_OFF, g, S, E);
        if (BOTH(7)) GRID_BAR();
    }
    if (IN(8)) { ln_pass(F, args.out, args.in[24], args.in[25], (bf16*)(ws + WS_H1B)); if (BOTH(8)) GRID_BAR(); }
    if (IN(9)) {
        pg8::Gemm g{(const pb*)(ws + WS_H1B), (const pb*)(ws + WS_WGU), MTOK, 2 * FFH, DM}; pg8::StaticOrder S; S.init(MTOK, 2 * FFH, F.G, (int)blockIdx.x);
        pg8::EpiSwiglu E{(pb*)(ws + WS_ACT)};
        pg8::gemm_phase<pg8::EpiSwiglu, pg8::StaticOrder, true, true>(F.lds + RING_OFF, g, S, E);
        if (BOTH(9)) GRID_BAR();
    }
    if (IN(10)) {
        pg8::Gemm g{(const pb*)(ws + WS_ACT), (const pb*)(ws + WS_WDN), MTOK, DM, FFH}; pg8::StaticOrder S; S.init(MTOK, DM, F.G, (int)blockIdx.x);
        pg8::EpiDownZ E{args.out};
        pg8::gemm_phase<pg8::EpiDownZ, pg8::StaticOrder, true, true>(F.lds + RING_OFF, g, S, E);
        if (BOTH(10)) GRID_BAR();
    }
    if (IN(11)) { ln_pass(F, args.out, args.in[29], args.in[30], nullptr); }
#undef IN
#undef BOTH
}

extern "C" void kernel_launch(void* const* d_in, const int* in_sizes, int n_in, void* d_out, int out_size, void* d_ws, size_t ws_size, hipStream_t stream) {
    static int grid = 0;
    if (grid == 0) {
        if (n_in != 31 || in_sizes[0] != MTOK * DM || out_size != MTOK * DM || ws_size < WS_END) { fprintf(stderr, "kernel_launch: unexpected shapes (n_in %d, in0 %d, out %d, ws %zu); nothing launched\n", n_in, n_in > 0 ? in_sizes[0] : -1, out_size, ws_size); grid = -1; return; }
        int dev = 0, cus = 0, per_cu = 0;
        if (hipGetDevice(&dev) != hipSuccess || hipDeviceGetAttribute(&cus, hipDeviceAttributeMultiprocessorCount, dev) != hipSuccess) { grid = -1; return; }
        if (hipFuncSetAttribute((const void*)fwd_kernel, hipFuncAttributeMaxDynamicSharedMemorySize, LDS_BYTES) != hipSuccess) { fprintf(stderr, "kernel_launch: hipFuncSetAttribute failed\n"); grid = -1; return; }
        if (hipOccupancyMaxActiveBlocksPerMultiprocessor(&per_cu, (const void*)fwd_kernel, NWAVES * 64, LDS_BYTES) != hipSuccess || per_cu < 1) { fprintf(stderr, "kernel_launch: occupancy query reports %d blocks per CU\n", per_cu); per_cu = 1; }
        (void)hipGetLastError();
        grid = cus;
    }
    if (grid < 0) return;
    if (hipMemsetAsync((char*)d_ws + WS_CTL, 0, CTL_ZERO_BYTES, stream) != hipSuccess) return;
    Args a{};
    for (int i = 0; i < 31; ++i) a.in[i] = (const float*)d_in[i];
    a.out = (float*)d_out; a.ws = (unsigned char*)d_ws;
#if MK_ONE_LAUNCH
    a.ph_lo = 0; a.ph_hi = NPHASE;
    hipLaunchKernelGGL(fwd_kernel, dim3(grid), dim3(NWAVES * 64), LDS_BYTES, stream, a);
#else
    for (int p = 0; p < NPHASE; ++p) { a.ph_lo = p; a.ph_hi = p + 1; hipLaunchKernelGGL(fwd_kernel, dim3(grid), dim3(NWAVES * 64), LDS_BYTES, stream, a); }
#endif
}
```
